# Optimizing an MI355X kernel written in HIP

```python
import jax, jax.numpy as jnp
from jax import lax
import numpy as np

D_MODEL = 1024
BATCH = 4
SEQ = 8192
DEPTH = 2

HEAD_DIM = 64
ROPE_THETA = 10000.0
EPS = 1e-6
NEG_INF = -1e30
Q_BLOCK = 128

MLA_HEADS = 8
MLA_Q_RANK = 256
MLA_KV_RANK = 128
MLA_NOPE_DIM = 64
MLA_ROPE_DIM = 32
MLA_V_DIM = 64
DIL_PATTERNS = ((128, 1), (512, 4), (2048, 16))
DIL_HEADS_PER_GROUP = 4
DIL_HEADS = DIL_HEADS_PER_GROUP * len(DIL_PATTERNS)
BAND_BLOCK = 128
NA_HEADS = 8
NA_KH = 8
NA_KW = 16
GRID_W = 64
N_BRANCH = 3
D_FF = -(-(8 * D_MODEL) // (3 * 256)) * 256

A_COLS = MLA_Q_RANK + MLA_KV_RANK + MLA_ROPE_DIM
B_COLS = 3 * DIL_HEADS * HEAD_DIM
C_COLS = 3 * NA_HEADS * HEAD_DIM
G_COLS = N_BRANCH * D_MODEL
IN_COLS = A_COLS + B_COLS + C_COLS + G_COLS
IN_SPLITS = (MLA_Q_RANK, MLA_Q_RANK + MLA_KV_RANK, A_COLS, A_COLS + B_COLS, A_COLS + B_COLS + C_COLS)
A_OUT = MLA_HEADS * MLA_V_DIM
B_OUT = DIL_HEADS_PER_GROUP * HEAD_DIM
C_OUT = NA_HEADS * HEAD_DIM

kernel_name = 'hybrid_mla_dilated_neighbourhood_encoder'


def rms_norm(x, g):
    xf = x.astype(jnp.float32)
    y = xf * lax.rsqrt(jnp.mean(xf * xf, axis=-1, keepdims=True) + EPS)
    return (y * g.astype(jnp.float32)).astype(x.dtype)


def rope_tables(seq_len, dim):
    pos = jnp.arange(seq_len, dtype=jnp.float32)
    inv = jnp.power(ROPE_THETA, -jnp.arange(0, dim, 2, dtype=jnp.float32) / dim)
    ang = pos[:, None] * inv[None, :]
    return jnp.cos(ang), jnp.sin(ang)


def apply_rope(x, cos, sin):
    xf = x.astype(jnp.float32)
    x1, x2 = jnp.split(xf, 2, axis=-1)
    return jnp.concatenate([x1 * cos - x2 * sin, x2 * cos + x1 * sin], axis=-1).astype(x.dtype)


def mla_mixer(c_q, c_kv, k_rope, g_q, g_kv, w_uq, w_ukv):
    B, S = c_q.shape[0], c_q.shape[1]
    q = (rms_norm(c_q, g_q) @ w_uq).reshape(B, S, MLA_HEADS, MLA_NOPE_DIM + MLA_ROPE_DIM)
    kv = (rms_norm(c_kv, g_kv) @ w_ukv).reshape(B, S, MLA_HEADS, MLA_NOPE_DIM + MLA_V_DIM)
    cos, sin = rope_tables(S, MLA_ROPE_DIM)
    q_nope = q[..., :MLA_NOPE_DIM]
    q_rope = apply_rope(q[..., MLA_NOPE_DIM:], cos[:, None], sin[:, None])
    k_nope, v = kv[..., :MLA_NOPE_DIM], kv[..., MLA_NOPE_DIM:]
    k_rope = apply_rope(k_rope, cos, sin)
    scale = (MLA_NOPE_DIM + MLA_ROPE_DIM) ** -0.5
    nb = S // Q_BLOCK

    def to_blocks(t):
        return t.reshape(B, nb, Q_BLOCK, *t.shape[2:]).swapaxes(0, 1)

    def attend(blk):
        qn, qr = blk
        s = (jnp.einsum('bqhd,bkhd->bhqk', qn, k_nope, preferred_element_type=jnp.float32)
             + jnp.einsum('bqhr,bkr->bhqk', qr, k_rope, preferred_element_type=jnp.float32)) * scale
        p = jax.nn.softmax(s, axis=-1).astype(v.dtype)
        return jnp.einsum('bhqk,bkhd->bqhd', p, v)

    o = lax.map(attend, (to_blocks(q_nope), to_blocks(q_rope)))
    return o.swapaxes(0, 1).reshape(B, S, A_OUT)


def banded_attention(q, k, v, radius):
    N, L, H, D = q.shape
    nb = -(-L // BAND_BLOCK)
    Lp = nb * BAND_BLOCK
    kw = BAND_BLOCK + 2 * radius
    qb = jnp.pad(q, ((0, 0), (0, Lp - L), (0, 0), (0, 0))).reshape(N, nb, BAND_BLOCK, H, D)
    pad_k = ((0, 0), (radius, Lp - L + radius), (0, 0), (0, 0))
    idx = jnp.arange(nb)[:, None] * BAND_BLOCK + jnp.arange(kw)[None, :]
    kb = jnp.pad(k, pad_k)[:, idx]
    vb = jnp.pad(v, pad_k)[:, idx]
    s = jnp.einsum('ncqhd,nckhd->nchqk', qb, kb, preferred_element_type=jnp.float32) * (D ** -0.5)
    qpos = jnp.arange(nb)[:, None] * BAND_BLOCK + jnp.arange(BAND_BLOCK)[None, :]
    kpos = (idx - radius)[:, None, :]
    mask = (jnp.abs(qpos[:, :, None] - kpos) <= radius) & (kpos >= 0) & (kpos < L)
    s = jnp.where(mask[None, :, None], s, NEG_INF)
    m = jnp.max(s, axis=-1, keepdims=True)
    e = jnp.exp(s - m)
    den = jnp.sum(e, axis=-1, keepdims=True)
    p = (e / den).astype(v.dtype)
    lse = (m + jnp.log(den))[..., 0]
    o = jnp.einsum('nchqk,nckhd->ncqhd', p, vb).reshape(N, Lp, H, D)[:, :L]
    lse = lse.transpose(0, 1, 3, 2).reshape(N, Lp, H)[:, :L]
    return o, lse


def dilated_mixer(q, k, v):
    B, S = q.shape[0], q.shape[1]
    H, D = DIL_HEADS_PER_GROUP, HEAD_DIM
    outs, lses = [], []
    for g, (window, dilation) in enumerate(DIL_PATTERNS):
        hs = slice(g * H, (g + 1) * H)
        L = S // dilation

        def split(t):
            return t[:, :, hs].reshape(B, L, dilation, H, D).swapaxes(1, 2).reshape(B * dilation, L, H, D)

        o, lse = banded_attention(split(q), split(k), split(v), window // (2 * dilation))
        outs.append(o.reshape(B, dilation, L, H, D).swapaxes(1, 2).reshape(B, S, H, D))
        lses.append(lse.reshape(B, dilation, L, H).swapaxes(1, 2).reshape(B, S, H))
    alpha = jax.nn.softmax(jnp.stack(lses), axis=0).astype(q.dtype)
    o = jnp.einsum('gbsh,gbshd->bshd', alpha, jnp.stack(outs))
    return o.reshape(B, S, B_OUT)


def neighbourhood_mixer(q, k, v, rpb):
    B, S, H, D = q.shape
    rows = S // GRID_W
    kh = min(NA_KH, rows)
    r = jnp.arange(rows)
    c = jnp.arange(GRID_W)
    rs = jnp.clip(r - kh // 2, 0, rows - kh)
    cs = jnp.clip(c - NA_KW // 2, 0, GRID_W - NA_KW)
    key_cols = cs[:, None] + jnp.arange(NA_KW)[None, :]
    dc = key_cols - c[:, None] + (NA_KW - 1)
    scale = D ** -0.5

    def attend_row(inp):
        q_row, r0, r_i = inp
        key_rows = r0 + jnp.arange(kh)
        idx = key_rows[None, :, None] * GRID_W + key_cols[:, None, :]
        kg = k[:, idx].reshape(B, GRID_W, kh * NA_KW, H, D)
        vg = v[:, idx].reshape(B, GRID_W, kh * NA_KW, H, D)
        dr = key_rows - r_i + (NA_KH - 1)
        bias = rpb[:, dr[None, :, None], dc[:, None, :]].reshape(H, GRID_W, kh * NA_KW)
        s = jnp.einsum('bchd,bcnhd->bhcn', q_row, kg, preferred_element_type=jnp.float32) * scale
        s = s + bias.astype(jnp.float32)[None]
        p = jax.nn.softmax(s, axis=-1).astype(v.dtype)
        return jnp.einsum('bhcn,bcnhd->bchd', p, vg)

    q_rows = q.reshape(B, rows, GRID_W, H, D).swapaxes(0, 1)
    o = lax.map(attend_row, (q_rows, rs, r))
    return o.swapaxes(0, 1).reshape(B, S, C_OUT)


def setup_inputs(seed: int = 0) -> dict:
    key = jax.random.key(seed)
    ks = jax.random.split(key, 17)

    def normal(k, shape, fan_in):
        return jax.random.normal(k, shape, jnp.float32) * (fan_in ** -0.5)

    def gain(k, shape):
        return 1.0 + 0.01 * jax.random.normal(k, shape, jnp.float32)

    return {
        'x': jax.random.normal(ks[0], (BATCH, SEQ, D_MODEL), jnp.float32),
        'w_in': normal(ks[1], (DEPTH, D_MODEL, IN_COLS), D_MODEL),
        'g_mix': gain(ks[2], (DEPTH, D_MODEL)),
        'g_q': gain(ks[3], (DEPTH, MLA_Q_RANK)),
        'g_kv': gain(ks[4], (DEPTH, MLA_KV_RANK)),
        'w_uq': normal(ks[5], (DEPTH, MLA_Q_RANK, MLA_HEADS * (MLA_NOPE_DIM + MLA_ROPE_DIM)), MLA_Q_RANK),
        'w_ukv': normal(ks[6], (DEPTH, MLA_KV_RANK, MLA_HEADS * (MLA_NOPE_DIM + MLA_V_DIM)), MLA_KV_RANK),
        'rpb': 0.1 * jax.random.normal(ks[7], (DEPTH, NA_HEADS, 2 * NA_KH - 1, 2 * NA_KW - 1), jnp.float32),
        'w_pa': normal(ks[8], (DEPTH, A_OUT, D_MODEL), A_OUT),
        'w_pb': normal(ks[9], (DEPTH, B_OUT, D_MODEL), B_OUT),
        'w_pc': normal(ks[10], (DEPTH, C_OUT, D_MODEL), C_OUT),
        'w_o': normal(ks[11], (DEPTH, D_MODEL, D_MODEL), D_MODEL),
        'g_ffn': gain(ks[12], (DEPTH, D_MODEL)),
        'w1': normal(ks[13], (DEPTH, D_MODEL, D_FF), D_MODEL),
        'w3': normal(ks[14], (DEPTH, D_MODEL, D_FF), D_MODEL),
        'w2': normal(ks[15], (DEPTH, D_FF, D_MODEL), D_FF),
        'g_final': gain(ks[16], (D_MODEL,)),
    }


def reference(x, w_in, g_mix, g_q, g_kv, w_uq, w_ukv, rpb, w_pa, w_pb, w_pc, w_o, g_ffn, w1, w3, w2, g_final):
    B, S = x.shape[0], x.shape[1]
    cos_b, sin_b = rope_tables(S, HEAD_DIM)
    for l in range(DEPTH):
        h = rms_norm(x, g_mix[l])
        proj = h @ w_in[l]
        c_q, c_kv, k_r, qkv_b, qkv_c, gate_logits = jnp.split(proj, IN_SPLITS, axis=-1)
        y_a = mla_mixer(c_q, c_kv, k_r, g_q[l], g_kv[l], w_uq[l], w_ukv[l])
        qkv_b = qkv_b.reshape(B, S, 3, DIL_HEADS, HEAD_DIM)
        q_b = apply_rope(qkv_b[:, :, 0], cos_b[:, None], sin_b[:, None])
        k_b = apply_rope(qkv_b[:, :, 1], cos_b[:, None], sin_b[:, None])
        y_b = dilated_mixer(q_b, k_b, qkv_b[:, :, 2])
        qkv_c = qkv_c.reshape(B, S, 3, NA_HEADS, HEAD_DIM)
        y_c = neighbourhood_mixer(qkv_c[:, :, 0], qkv_c[:, :, 1], qkv_c[:, :, 2], rpb[l])
        gates = jax.nn.sigmoid(gate_logits.astype(jnp.float32)).astype(x.dtype).reshape(B, S, N_BRANCH, D_MODEL)
        merged = (gates[:, :, 0] * (y_a @ w_pa[l])
                  + gates[:, :, 1] * (y_b @ w_pb[l])
                  + gates[:, :, 2] * (y_c @ w_pc[l]))
        x = x + merged @ w_o[l]
        h = rms_norm(x, g_ffn[l])
        x = x + (jax.nn.silu(h @ w1[l]) * (h @ w3[l])) @ w2[l]
    return rms_norm(x, g_final)
```

```cpp
#include <hip/hip_runtime.h>
#include <hip/hip_cooperative_groups.h>
#include <cstdio>
namespace cg = cooperative_groups;

typedef unsigned short u16;
typedef __attribute__((ext_vector_type(8))) short bf16x8;
typedef __attribute__((ext_vector_type(4))) short s16x4;
typedef __attribute__((ext_vector_type(16))) float f32x16;
typedef __attribute__((ext_vector_type(4))) float f32x4;
typedef __attribute__((ext_vector_type(2))) __bf16 bf16v2;
typedef __attribute__((ext_vector_type(4))) unsigned u32x4;
typedef __attribute__((ext_vector_type(2))) unsigned u32x2;
#define DI __device__ __forceinline__
#define LAS __attribute__((address_space(3)))
#define MFMA(a, b, c) __builtin_amdgcn_mfma_f32_32x32x16_bf16((a), (b), (c), 0, 0, 0)

constexpr int NT = 512;
constexpr int T = 32768;
constexpr int SEQ = 8192;
constexpr float LOG2E = 1.4426950408889634f;
constexpr float LN2 = 0.6931471805599453f;
constexpr float EPS = 1e-6f;

constexpr size_t MiB = 1024ull * 1024ull;
constexpr size_t OFF_W = 0;
constexpr size_t OFF_CS64 = 40 * MiB;
constexpr size_t OFF_CS32 = 42 * MiB;
constexpr size_t OFF_RSQ = 43 * MiB;
constexpr size_t OFF_BAR = 43 * MiB + 512 * 1024;
constexpr size_t OFF_H = 44 * MiB;
constexpr size_t OFF_CQ = 108 * MiB;
constexpr size_t OFF_CKV = 124 * MiB;
constexpr size_t OFF_KROPE = 132 * MiB;
constexpr size_t OFF_QA = 134 * MiB;
constexpr size_t OFF_KVA = 182 * MiB;
constexpr size_t OFF_QKVB = 246 * MiB;
constexpr size_t OFF_QKVC = 390 * MiB;
constexpr size_t OFF_PQ = 486 * MiB;
constexpr size_t OFF_PKV = 486 * MiB + 512 * 1024;
constexpr size_t OFF_PA = 487 * MiB;
constexpr size_t OFF_PB = 489 * MiB;
constexpr size_t W_IN = 0;
constexpr size_t W_G = W_IN + 4352ull * 1024;
constexpr size_t W_UQ = W_G + 3072ull * 1024;
constexpr size_t W_UKV = W_UQ + 768ull * 256;
constexpr size_t W_PA = W_UKV + 1024ull * 128;
constexpr size_t W_PB = W_PA + 1024ull * 512;
constexpr size_t W_PC = W_PB + 1024ull * 256;
constexpr size_t W_O = W_PC + 1024ull * 512;
constexpr size_t W_13 = W_O + 1024ull * 1024;
constexpr size_t W_2 = W_13 + 5632ull * 1024;

struct Params {
  const float *x, *w_in, *g_mix, *g_q, *g_kv, *w_uq, *w_ukv, *rpb, *w_pa, *w_pb, *w_pc, *w_o, *g_ffn, *w1, *w3, *w2, *g_final;
  float* out;
  char* ws;
};

DI unsigned pack2(float a, float b) {
  bf16v2 v; v[0] = (__bf16)a; v[1] = (__bf16)b;
  return __builtin_bit_cast(unsigned, v);
}
DI u16 f2bf(float a) { return __builtin_bit_cast(u16, (__bf16)a); }
DI float bflo(unsigned u) { return __uint_as_float(u << 16); }
DI float bfhi(unsigned u) { return __uint_as_float(u & 0xffff0000u); }
DI int tid_l() { int t = threadIdx.x; asm volatile("" : "+v"(t)); return t; }
DI int gdim_l() { int g = gridDim.x; asm volatile("" : "+s"(g)); return g; }
DI float shx(float v, int m, int lane) { return __int_as_float(__builtin_amdgcn_ds_bpermute((lane ^ m) << 2, __float_as_int(v))); }
DI float xhalf_max(float v) {
  const auto r = __builtin_amdgcn_permlane32_swap(__float_as_uint(v), __float_as_uint(v), false, false);
  return fmaxf(__uint_as_float(r[0]), __uint_as_float(r[1]));
}
DI float xhalf_sum(float v) {
  const auto r = __builtin_amdgcn_permlane32_swap(__float_as_uint(v), __float_as_uint(v), false, false);
  return __uint_as_float(r[0]) + __uint_as_float(r[1]);
}
DI float xrows_sum(float v) {
  const auto a = __builtin_amdgcn_permlane16_swap(__float_as_uint(v), __float_as_uint(v), false, false);
  const float s = __uint_as_float(a[0]) + __uint_as_float(a[1]);
  const auto b = __builtin_amdgcn_permlane32_swap(__float_as_uint(s), __float_as_uint(s), false, false);
  return __uint_as_float(b[0]) + __uint_as_float(b[1]);
}
DI u32x4 widen_pair(u32x2 x, u32x2 y) {
  const auto a = __builtin_amdgcn_permlane32_swap(x.x, y.x, false, false);
  const auto b = __builtin_amdgcn_permlane32_swap(x.y, y.y, false, false);
  return (u32x4){a[0], b[0], a[1], b[1]};
}
DI float wave_sum(float v, int lane) {
#pragma unroll
  for (int m = 32; m >= 1; m >>= 1) v += shx(v, m, lane);
  return v;
}
DI int bid_l() { int b = blockIdx.x; asm volatile("" : "+s"(b)); return b; }
DI char* ptr_l(char* q) { size_t z = 0; asm volatile("" : "+s"(z)); return q + z; }
DI int crow(int reg, int hh) { return (reg & 3) + 8 * (reg >> 2) + 4 * hh; }
DI float sigmoidf_(float x) { return __builtin_amdgcn_rcpf(1.f + __builtin_amdgcn_exp2f(-x * LOG2E)); }
DI int p64(int d) { return 8 * ((d & 31) >> 2) + (d & 3) + 4 * (d >> 5); }
DI int p32(int d) { return 8 * ((d & 15) >> 2) + (d & 3) + 4 * (d >> 4); }


#define XB_TMO      128
#define XB_XCNT(j)  (256  + 64 * (j))
#define XB_XSUB(j)  (1280 + 64 * (j))
#define XB_XGEN(j)  (2304 + 64 * (j))
#define XB_TOP      3328
#define XB_TOPGEN   3392
#define XB_CENSUS(j) (3456 + 64 * (j))
#define XCD_BAR_WORDS 4096
#define XB_SPIN_CAP (1u << 18)
DI unsigned xb_ld(unsigned* p) { return __hip_atomic_load(p, __ATOMIC_RELAXED, __HIP_MEMORY_SCOPE_AGENT); }
DI unsigned xb_add(unsigned* p, unsigned v) { return __hip_atomic_fetch_add(p, v, __ATOMIC_RELAXED, __HIP_MEMORY_SCOPE_AGENT); }
DI unsigned xb_xcc_id() { return (unsigned)__builtin_amdgcn_s_getreg((3 << 11) | 20) & 0xFu; }
#define XB_SPIN(cond, bar) do { unsigned _sp = 0; while (cond) { __builtin_amdgcn_s_sleep(1); \
    if ((++_sp & 255u) == 0u) { if (xb_ld(&(bar)[XB_TMO])) break; if (_sp > XB_SPIN_CAP) { atomicAdd(&(bar)[XB_TMO], 1u); break; } } } } while (0)
struct XcdBarrier { unsigned* bar; unsigned x; volatile LAS unsigned* st; };
DI XcdBarrier xcd_barrier_post(unsigned* bar, volatile LAS unsigned* st) {
  XcdBarrier b; b.bar = bar; b.x = xb_xcc_id(); b.st = st;
  if (threadIdx.x == 0) (void)xb_add(&bar[XB_XCNT(b.x)], 1u);
  return b;
}
DI void xcd_barrier_complete(unsigned* bar, unsigned x, unsigned& nloc, unsigned& nx) {
  const unsigned G = gridDim.x * gridDim.y * gridDim.z;
  unsigned sum, cnt, mine, sp = 0u;
  for (;;) {
    sum = 0u; cnt = 0u; mine = 0u;
#pragma unroll
    for (unsigned j = 0; j < 16; ++j) { const unsigned c = xb_ld(&bar[XB_XCNT(j)]); sum += c; cnt += (c > 0u) ? 1u : 0u; mine = (j == x) ? c : mine; }
    if (sum == G) break;
    __builtin_amdgcn_s_sleep(1);
    if ((++sp & 255u) == 0u) { if (xb_ld(&bar[XB_TMO])) break; if (sp > XB_SPIN_CAP) { atomicAdd(&bar[XB_TMO], 1u); break; } }
  }
  nloc = mine > 0u ? mine : 1u; nx = cnt > 0u ? cnt : 1u;
}
DI void xcd_barrier(const XcdBarrier& b) {
  asm volatile("s_waitcnt vmcnt(0)" ::: "memory");
  __syncthreads();
  if (threadIdx.x == 0) {
    unsigned* bar = b.bar;
    __builtin_amdgcn_s_waitcnt(0);
    unsigned nloc = b.st[0], nx = b.st[1];
    if (nloc == 0u) { xcd_barrier_complete(bar, b.x, nloc, nx); b.st[0] = nloc; b.st[1] = nx; }
    const unsigned old = xb_add(&bar[XB_XSUB(b.x)], 1u);
    const unsigned gen = old / nloc;
    if (old + 1u == (gen + 1u) * nloc) {
      __builtin_amdgcn_fence(__ATOMIC_RELEASE, "agent");
      asm volatile("s_waitcnt vmcnt(0)" ::: "memory");
      const unsigned og = xb_add(&bar[XB_TOP], 1u);
      const unsigned tg = og / nx;
      if (og + 1u == (tg + 1u) * nx) xb_add(&bar[XB_TOPGEN], 1u);
      else XB_SPIN(xb_ld(&bar[XB_TOPGEN]) == tg, bar);
      __builtin_amdgcn_fence(__ATOMIC_ACQUIRE, "agent");
      xb_add(&bar[XB_XGEN(b.x)], 1u);
      asm volatile("s_waitcnt vmcnt(0)" ::: "memory");
    } else {
      XB_SPIN(xb_ld(&bar[XB_XGEN(b.x)]) == gen, bar);
      __builtin_amdgcn_fence(__ATOMIC_ACQUIRE, "agent");
      asm volatile("s_waitcnt vmcnt(0)" ::: "memory");
    }
  }
  __syncthreads();
}

DI int conv_dst_row(int mode, int r0, int c) {
  if (mode == 1) return r0 + (c & ~63) + p64(c & 63);
  if (mode == 2) return ((c >> 5) % 3 == 2) ? (r0 + (c & ~31) + p32(c & 31)) : (r0 + c);
  if (mode == 3) return r0 + p32(c & 31);
  if (mode == 4) return r0 + (c >> 7) * 256 + (c & 127);
  return r0 + c;
}
DI void conv_job(const float* __restrict__ src, int K, int ld, int c0, int ncols, u16* __restrict__ dst, int r0, int mode,
                 const float* __restrict__ g, u16* sm, int& base) {
  const int nct = (ncols + 63) >> 6, nkt = K >> 6, ntile = nct * nkt;
  const int t = tid_l();
  const int G = gdim_l();
  int first = (bid_l() - (base % G) + G) % G;
  base += ntile;
  for (int tile = first; tile < ntile; tile += G) {
    const int ct = tile % nct, kt = tile / nct;
    const int c = t & 63, kk = t >> 6;
    const bool cv = (ct * 64 + c) < ncols;
    __syncthreads();
#pragma unroll 4
    for (int i = 0; i < 8; ++i) {
      const int k = kk + 8 * i;
      float v = cv ? src[(size_t)(kt * 64 + k) * ld + c0 + ct * 64 + c] : 0.f;
      if (g) v *= g[kt * 64 + k];
      sm[c * 66 + k] = f2bf(v);
    }
    __syncthreads();
    const int row = t >> 3, part = t & 7;
    if (ct * 64 + row < ncols) {
      const unsigned* s32 = (const unsigned*)(sm + row * 66 + part * 8);
      u32x4 a;
      a.x = s32[0]; a.y = s32[1]; a.z = s32[2]; a.w = s32[3];
      u16* d = dst + (size_t)conv_dst_row(mode, r0, ct * 64 + row) * K + kt * 64 + part * 8;
      *(u32x4*)d = a;
    }
  }
}

DI void conv_layer(const Params& p, int l, u16* sm) {
  u16* W = (u16*)(ptr_l(p.ws) + OFF_W);
  int base = 0;
  const float* win = p.w_in + (size_t)l * 1024 * 7328;
  const float* gm = p.g_mix + l * 1024;
  const float* gf = p.g_ffn + l * 1024;
  conv_job(win, 1024, 7328, 416, 1536, W + W_IN, 512, 1, gm, sm, base);
  conv_job(win, 1024, 7328, 416 + 1536, 768 + 1536, W + W_IN, 2048, 0, gm, sm, base);
  conv_job(win, 1024, 7328, 4256, 3072, W + W_G, 0, 0, gm, sm, base);
  conv_job(p.w1 + (size_t)l * 1024 * 2816, 1024, 2816, 0, 2816, W + W_13, 0, 4, gf, sm, base);
  conv_job(p.w3 + (size_t)l * 1024 * 2816, 1024, 2816, 0, 2816, W + W_13, 128, 4, gf, sm, base);
  conv_job(p.w2 + (size_t)l * 2816 * 1024, 2816, 1024, 0, 1024, W + W_2, 0, 0, nullptr, sm, base);
  conv_job(p.w_o + (size_t)l * 1024 * 1024, 1024, 1024, 0, 1024, W + W_O, 0, 0, nullptr, sm, base);
  conv_job(win, 1024, 7328, 0, 384, W + W_IN, 0, 0, gm, sm, base);
  conv_job(win, 1024, 7328, 384, 32, W + W_IN, 384, 3, gm, sm, base);
  conv_job(p.w_pa + (size_t)l * 512 * 1024, 512, 1024, 0, 1024, W + W_PA, 0, 0, nullptr, sm, base);
  conv_job(p.w_pc + (size_t)l * 512 * 1024, 512, 1024, 0, 1024, W + W_PC, 0, 0, nullptr, sm, base);
  conv_job(p.w_pb + (size_t)l * 256 * 1024, 256, 1024, 0, 1024, W + W_PB, 0, 0, nullptr, sm, base);
  conv_job(p.w_uq + (size_t)l * 256 * 768, 256, 768, 0, 768, W + W_UQ, 0, 2, p.g_q + l * 256, sm, base);
  conv_job(p.w_ukv + (size_t)l * 128 * 1024, 128, 1024, 0, 1024, W + W_UKV, 0, 0, p.g_kv + l * 128, sm, base);
}

DI void rope_tables(const Params& p) {
  char* ws = ptr_l(p.ws);
  float2* cs64 = (float2*)(ws + OFF_CS64);
  float2* cs32 = (float2*)(ws + OFF_CS32);
  const int stride = gdim_l() * NT;
  for (int i = bid_l() * NT + tid_l(); i < SEQ * 48; i += stride) {
    int pos; float ex; float2* dst;
    if (i < SEQ * 32) { pos = i >> 5; ex = (float)(i & 31) * (1.f / 32.f); dst = cs64 + i; }
    else { const int j = i - SEQ * 32; pos = j >> 4; ex = (float)(j & 15) * (1.f / 16.f); dst = cs32 + j; }
    const float inv = __builtin_amdgcn_exp2f(-ex * 13.287712379549449f);
    const float ang = (float)pos * inv;
    const double tt = (double)ang * 0.15915494309189535;
    const float fr = (float)(tt - floor(tt));
    *dst = make_float2(__builtin_amdgcn_cosf(fr), __builtin_amdgcn_sinf(fr));
  }
}
DI void zero_f32(float* r, int n) {
  const int stride = gdim_l() * NT;
  for (int i = bid_l() * NT + tid_l(); i < n; i += stride) r[i] = 0.f;
}

DI void x16_rows(const float* __restrict__ x, u16* __restrict__ out, float* __restrict__ rowsq) {
  const int t_ = tid_l(); const int lane = t_ & 63, w = t_ >> 6;
  for (int row = bid_l() * 8 + w; row < T; row += gdim_l() * 8) {
    const float4* xr = (const float4*)(x + (size_t)row * 1024);
    float4 v[4]; float ss = 0.f;
#pragma unroll
    for (int i = 0; i < 4; ++i) { v[i] = xr[lane + 64 * i]; ss += v[i].x * v[i].x + v[i].y * v[i].y + v[i].z * v[i].z + v[i].w * v[i].w; }
    ss = wave_sum(ss, lane);
    if (lane < 16) rowsq[(size_t)row * 16 + lane] = (lane == 0) ? ss : 0.f;
#pragma unroll
    for (int i = 0; i < 4; ++i) {
      u32x2 o; o.x = pack2(v[i].x, v[i].y); o.y = pack2(v[i].z, v[i].w);
      *(u32x2*)(out + (size_t)row * 1024 + 4 * (lane + 64 * i)) = o;
    }
  }
}
DI void scale_rows_f32(float* __restrict__ x, const float* __restrict__ rowsq, const float* __restrict__ g) {
  const int t_ = tid_l(); const int lane = t_ & 63, w = t_ >> 6;
  for (int row = bid_l() * 8 + w; row < T; row += gdim_l() * 8) {
    float4* xr = (float4*)(x + (size_t)row * 1024);
    float sq_ = 0.f;
    { const f32x4* pr_ = (const f32x4*)rowsq + (size_t)row * 4;
#pragma unroll
      for (int j = 0; j < 4; ++j) { const f32x4 q_ = pr_[j]; sq_ += (q_[0] + q_[1]) + (q_[2] + q_[3]); } }
    const float rs = rsqrtf(sq_ * (1.f / 1024.f) + EPS);
#pragma unroll
    for (int i = 0; i < 4; ++i) {
      const float4 v = xr[lane + 64 * i];
      const float4 gg = ((const float4*)g)[lane + 64 * i];
      xr[lane + 64 * i] = make_float4(v.x * rs * gg.x, v.y * rs * gg.y, v.z * rs * gg.z, v.w * rs * gg.w);
    }
  }
}
DI void scale_rows_from16(const u16* __restrict__ x16, float* __restrict__ out, const float* __restrict__ rowsq, const float* __restrict__ g) {
  const int t_ = tid_l(); const int lane = t_ & 63, w = t_ >> 6;
  for (int row = bid_l() * 8 + w; row < T; row += gdim_l() * 8) {
    const u32x4* xr = (const u32x4*)(x16 + (size_t)row * 1024);
    float4* orow = (float4*)(out + (size_t)row * 1024);
    const float rs = rsqrtf(rowsq[row] * (1.f / 1024.f) + EPS);
#pragma unroll
    for (int i = 0; i < 2; ++i) {
      const u32x4 v = xr[lane + 64 * i];
      const float4 g0 = ((const float4*)g)[2 * (lane + 64 * i)], g1 = ((const float4*)g)[2 * (lane + 64 * i) + 1];
      orow[2 * (lane + 64 * i)] = make_float4(bflo(v.x) * rs * g0.x, bfhi(v.x) * rs * g0.y, bflo(v.y) * rs * g0.z, bfhi(v.y) * rs * g0.w);
      orow[2 * (lane + 64 * i) + 1] = make_float4(bflo(v.z) * rs * g1.x, bfhi(v.z) * rs * g1.y, bflo(v.w) * rs * g1.z, bfhi(v.w) * rs * g1.w);
    }
  }
}
DI void norm_rows_bf16(const float* __restrict__ x, const float* __restrict__ g, u16* __restrict__ out) {
  const int t_ = tid_l(); const int lane = t_ & 63, w = t_ >> 6;
  for (int row = bid_l() * 8 + w; row < T; row += gdim_l() * 8) {
    const float4* xr = (const float4*)(x + (size_t)row * 1024);
    float4 v[4]; float ss = 0.f;
#pragma unroll
    for (int i = 0; i < 4; ++i) { v[i] = xr[lane + 64 * i]; ss += v[i].x * v[i].x + v[i].y * v[i].y + v[i].z * v[i].z + v[i].w * v[i].w; }
    ss = wave_sum(ss, lane);
    const float rs = rsqrtf(ss * (1.f / 1024.f) + EPS);
#pragma unroll
    for (int i = 0; i < 4; ++i) {
      const float4 gg = ((const float4*)g)[lane + 64 * i];
      u32x2 o; o.x = pack2(v[i].x * rs * gg.x, v[i].y * rs * gg.y); o.y = pack2(v[i].z * rs * gg.z, v[i].w * rs * gg.w);
      *(u32x2*)(out + (size_t)row * 1024 + 4 * (lane + 64 * i)) = o;
    }
  }
}
DI void norm_rows_f32(float* __restrict__ x, const float* __restrict__ g) {
  const int t_ = tid_l(); const int lane = t_ & 63, w = t_ >> 6;
  for (int row = bid_l() * 8 + w; row < T; row += gdim_l() * 8) {
    float4* xr = (float4*)(x + (size_t)row * 1024);
    float4 v[4]; float ss = 0.f;
#pragma unroll
    for (int i = 0; i < 4; ++i) { v[i] = xr[lane + 64 * i]; ss += v[i].x * v[i].x + v[i].y * v[i].y + v[i].z * v[i].z + v[i].w * v[i].w; }
    ss = wave_sum(ss, lane);
    const float rs = rsqrtf(ss * (1.f / 1024.f) + EPS);
#pragma unroll
    for (int i = 0; i < 4; ++i) {
      const float4 gg = ((const float4*)g)[lane + 64 * i];
      xr[lane + 64 * i] = make_float4(v[i].x * rs * gg.x, v[i].y * rs * gg.y, v[i].z * rs * gg.z, v[i].w * rs * gg.w);
    }
  }
}

constexpr int HTB = 128 * 64 * 2;
DI int lds_byte(int r, int c) { const int st = (r >> 4) * 2 + (c >> 5), rr = r & 15, cc = c & 31, ob = rr * 64 + cc * 2; return st * 1024 + (ob ^ (((ob >> 9) & 1) << 5)); }
DI void stage_rc(int b, int& R, int& C) { const int st = b / 1024, sb = b % 1024, swz = sb ^ (((sb >> 9) & 1) << 5); R = (st >> 1) * 16 + swz / 64; C = (st & 1) * 32 + (swz % 64) / 2; }
DI int perm32(int rho) { const int n = rho >> 4, i = rho & 15; return 8 * (i >> 2) + 4 * n + (i & 3); }

struct GUnit {
  const char* A;
  const char* B;
  int lda;
  int akb;
  int nt;
  int pm, pn, tag;
};

DI void static_tile(int L, int nM, int nN, int& pm, int& pn) {
#ifdef GEMM_ROWMAJ
  pm = L / nN; pn = L - pm * nN; return;
#endif
  const int nwg = nM * nN;
  int wgid = L;
  { const int q = nwg / 8, r = nwg % 8, xcd = wgid % 8, off = wgid / 8; wgid = (xcd < r ? xcd * (q + 1) : r * (q + 1) + (xcd - r) * q) + off; }
#ifndef WGM_
#define WGM_ 8
#endif
  const int nig = WGM_ * nN, gid = wgid / nig, fm = gid * WGM_, gsz = (nM - fm) < WGM_ ? (nM - fm) : WGM_;
  pm = fm + ((wgid % nig) % gsz); pn = (wgid % nig) / gsz;
}

template <bool PERM, bool UNI, bool RS, class Sched, class Epi>
DI void gemm_phase(LAS unsigned char* lds, const Sched& S, const Epi& E, const float* rsq = nullptr, float inv_n = 0.f, int np4 = 1) {
  const int tid = tid_l();
  const int wid = __builtin_amdgcn_readfirstlane(tid >> 6), lane = tid & 63, wr = wid >> 2, wc = wid & 3, fr = lane & 15, fq = lane >> 4;
  int R0, C0, R1, C1;
  stage_rc(tid * 16, R0, C0); stage_rc(tid * 16 + 8192, R1, C1);
  const int Rb0 = PERM ? ((R0 & ~31) + perm32(R0 & 31)) : R0, Rb1 = PERM ? ((R1 & ~31) + perm32(R1 & 31)) : R1;
  const unsigned ldsw = (unsigned)wid * 1024u;
  const int aoff = lds_byte(wr * 64 + fr, fq * 8), boff = lds_byte(wc * 32 + fr, fq * 8);
#define G_SA(b, h) (((b) * 2 + (h)) * HTB)
#define G_SB(b, h) ((4 + (b) * 2 + (h)) * HTB)
#define G_STAGE(bufoff, gbase, v0, v1) do { \
    __builtin_amdgcn_global_load_lds((const unsigned*)((const char*)(gbase) + (v0)), (LAS unsigned*)(lds + (bufoff) + ldsw), 16, 0, 0); \
    __builtin_amdgcn_global_load_lds((const unsigned*)((const char*)(gbase) + (v1)), (LAS unsigned*)(lds + (bufoff) + ldsw + 8192), 16, 0, 0); } while (0)
#define G_LDA(dst, b, h) do { _Pragma("unroll") for (int m = 0; m < 4; ++m) _Pragma("unroll") for (int k = 0; k < 2; ++k) dst[m][k] = *(const LAS bf16x8*)(lds + G_SA(b, h) + aoff + m * 2048 + k * 1024); } while (0)
#define G_LDB(dst, b, h) do { _Pragma("unroll") for (int n = 0; n < 2; ++n) _Pragma("unroll") for (int k = 0; k < 2; ++k) dst[n][k] = *(const LAS bf16x8*)(lds + G_SB(b, h) + boff + n * 2048 + k * 1024); } while (0)
#define G_MMA(ai, bj, At, Bt) do { __builtin_amdgcn_s_setprio(1); _Pragma("unroll") for (int m = 0; m < 4; ++m) _Pragma("unroll") for (int n = 0; n < 2; ++n) _Pragma("unroll") for (int k = 0; k < 2; ++k) \
    acc[ai][bj][m][n] = __builtin_amdgcn_mfma_f32_16x16x32_bf16(Bt[n][k], At[m][k], acc[ai][bj][m][n], 0, 0, 0); __builtin_amdgcn_s_setprio(0); } while (0)
#define G_WAIT_V(n) asm volatile("s_waitcnt vmcnt(" #n ")" ::: "memory")
#define G_WAIT_L(n) asm volatile("s_waitcnt lgkmcnt(" #n ")" ::: "memory")
#define G_BAR __builtin_amdgcn_s_barrier()
#define G_SCHED __builtin_amdgcn_sched_barrier(0)
#define G_MKOFF(u, a0, a1, b0, b1) do { a0 = (unsigned)(R0 * (u).lda + C0) * 2u; a1 = (unsigned)(R1 * (u).lda + C1) * 2u; \
    const int K_ = (u).nt * 64; b0 = (unsigned)(Rb0 * K_ + C0) * 2u; b1 = (unsigned)(Rb1 * K_ + C1) * 2u; } while (0)
  GUnit cur, nxt;
  int ui = 0;
  if (!S.next(0, cur)) return;
  f32x4 acc[2][2][4][2];
#pragma unroll
  for (int a = 0; a < 2; ++a)
#pragma unroll
    for (int b = 0; b < 2; ++b)
#pragma unroll
      for (int m = 0; m < 4; ++m)
#pragma unroll
        for (int n = 0; n < 2; ++n) acc[a][b][m][n] = (f32x4){0.f, 0.f, 0.f, 0.f};
  bf16x8 At[4][2], B0[2][2], B1[2][2];
  unsigned vA0, vA1, vB0, vB1;
  G_MKOFF(cur, vA0, vA1, vB0, vB1);
  LAS float* rstab = (LAS float*)(lds + 131072);
  if (RS && tid < 256) {
    const f32x4* pr_ = (const f32x4*)rsq + (size_t)(cur.pm * 256 + tid) * np4; float s_ = 0.f;
    for (int j = 0; j < np4; ++j) { const f32x4 q_ = pr_[j]; s_ += (q_[0] + q_[1]) + (q_[2] + q_[3]); }
    rstab[tid] = rsqrtf(s_ * inv_n + EPS);
  }
  const char* cA = cur.A; const char* cB = cur.B;
  size_t hA = (size_t)128 * cur.lda * 2, hB = (size_t)128 * cur.nt * 128, kA = (size_t)cur.akb;
  G_STAGE(G_SB(0, 0), cB, vB0, vB1); G_STAGE(G_SA(0, 0), cA, vA0, vA1); G_STAGE(G_SB(0, 1), cB + hB, vB0, vB1); G_STAGE(G_SA(0, 1), cA + hA, vA0, vA1);
  if (wr == 1) G_BAR;
  G_WAIT_V(4); G_BAR;
  G_STAGE(G_SB(1, 0), cB + 128, vB0, vB1); G_STAGE(G_SA(1, 0), cA + kA, vA0, vA1); G_STAGE(G_SB(1, 1), cB + hB + 128, vB0, vB1);
  G_WAIT_V(6); G_BAR;
  for (;;) {
    const bool has_next = S.next(ui + 1, nxt);
    unsigned nA0 = vA0, nA1 = vA1, nB0 = vB0, nB1 = vB1;
    const char* nA = cA; const char* nB = cB;
    size_t hAn = hA, hBn = hB, kAn = kA;
    if (has_next) { nA = nxt.A; nB = nxt.B; if (!UNI) { G_MKOFF(nxt, nA0, nA1, nB0, nB1); hAn = (size_t)128 * nxt.lda * 2; hBn = (size_t)128 * nxt.nt * 128; kAn = (size_t)nxt.akb; } }
    const int nt = cur.nt;
    for (int t = 0; t < nt; t += 2) {
      const bool last = (t == nt - 2);
      const char* a1 = cA + (size_t)(t + 1) * kA;
      const char* a2 = last ? nA : cA + (size_t)(t + 2) * kA;
      const char* b2 = last ? nB : cB + (size_t)(t + 2) * 128;
      const char* a3 = a2 + ((!UNI && last) ? kAn : kA);
      const char* b3 = b2 + 128;
      const unsigned xA0 = (!UNI && last) ? nA0 : vA0, xA1 = (!UNI && last) ? nA1 : vA1, xB0 = (!UNI && last) ? nB0 : vB0, xB1 = (!UNI && last) ? nB1 : vB1;
      const size_t xhA = (!UNI && last) ? hAn : hA, xhB = (!UNI && last) ? hBn : hB;
      G_LDB(B0, 0, 0); G_SCHED; G_LDA(At, 0, 0); G_STAGE(G_SA(1, 1), a1 + hA, vA0, vA1);
      G_WAIT_L(8); G_BAR; G_WAIT_L(0); G_MMA(0, 0, At, B0); G_BAR; G_SCHED;
      G_LDB(B1, 0, 1); G_STAGE(G_SB(0, 0), b2, xB0, xB1);
      G_BAR; G_WAIT_L(0); G_MMA(0, 1, At, B1); G_BAR;
      G_LDA(At, 0, 1); G_STAGE(G_SA(0, 0), a2, xA0, xA1);
      G_BAR; G_WAIT_L(0); G_MMA(1, 0, At, B0); G_BAR; G_SCHED;
      G_STAGE(G_SB(0, 1), b2 + xhB, xB0, xB1);
      G_WAIT_V(6); G_BAR; G_MMA(1, 1, At, B1); G_BAR;
      G_LDB(B0, 1, 0); G_SCHED; G_LDA(At, 1, 0); G_STAGE(G_SA(0, 1), a2 + xhA, xA0, xA1);
      G_WAIT_L(8); G_BAR; G_WAIT_L(0); G_MMA(0, 0, At, B0); G_BAR; G_SCHED;
      G_LDB(B1, 1, 1); G_STAGE(G_SB(1, 0), b3, xB0, xB1);
      G_BAR; G_WAIT_L(0); G_MMA(0, 1, At, B1); G_BAR;
      G_LDA(At, 1, 1); G_STAGE(G_SA(1, 0), a3, xA0, xA1);
      G_BAR; G_WAIT_L(0); G_MMA(1, 0, At, B0); G_BAR; G_SCHED;
      G_STAGE(G_SB(1, 1), b3 + xhB, xB0, xB1);
      G_WAIT_V(6); G_BAR; G_MMA(1, 1, At, B1); G_BAR;
    }
    float rnext_ = 0.f;
    if (RS && has_next && tid < 256) {
      const f32x4* pr_ = (const f32x4*)rsq + (size_t)(nxt.pm * 256 + tid) * np4;
      for (int j = 0; j < np4; ++j) { const f32x4 q_ = pr_[j]; rnext_ += (q_[0] + q_[1]) + (q_[2] + q_[3]); }
    }
    E(acc, cur, wr, wc, fr, fq, rstab + (ui & 1) * 256);
    if (RS && has_next && tid < 256) rstab[((ui + 1) & 1) * 256 + tid] = rsqrtf(rnext_ * inv_n + EPS);
    if (!has_next) break;
    if (!(Epi::CARRY && cur.tag < 2)) {
#pragma unroll
      for (int a = 0; a < 2; ++a)
#pragma unroll
        for (int b = 0; b < 2; ++b)
#pragma unroll
          for (int m = 0; m < 4; ++m)
#pragma unroll
            for (int n = 0; n < 2; ++n) acc[a][b][m][n] = (f32x4){0.f, 0.f, 0.f, 0.f};
    }
    cur = nxt; cA = nA; cB = nB; vA0 = nA0; vA1 = nA1; vB0 = nB0; vB1 = nB1; hA = hAn; hB = hBn; kA = kAn; ++ui;
  }
  G_WAIT_V(0);
  if (wr == 0) G_BAR;
  G_BAR;
#undef G_SA
#undef G_SB
#undef G_STAGE
#undef G_LDA
#undef G_LDB
#undef G_MMA
#undef G_WAIT_V
#undef G_WAIT_L
#undef G_BAR
#undef G_SCHED
#undef G_MKOFF
}

struct SchedSimple {
  const char* A; const char* B; int lda, akb, nt, nN, G, c;
  DI bool next(int i, GUnit& u) const {
    const int L = i * G + c;
    if (L >= 128 * nN) return false;
    static_tile(L, 128, nN, u.pm, u.pn);
    u.A = A + (size_t)u.pm * 256 * lda * 2; u.B = B + (size_t)u.pn * 256 * nt * 128;
    u.lda = lda; u.akb = akb; u.nt = nt; u.tag = 0;
    return true;
  }
};

DI u32x4 pack8(const f32x4 a, const f32x4 b) {
  u32x4 w; w.x = pack2(a[0], a[1]); w.y = pack2(a[2], a[3]); w.z = pack2(b[0], b[1]); w.w = pack2(b[2], b[3]); return w;
}
DI float sumsq8(const f32x4 a, const f32x4 b) {
  return a[0] * a[0] + a[1] * a[1] + a[2] * a[2] + a[3] * a[3] + b[0] * b[0] + b[1] * b[1] + b[2] * b[2] + b[3] * b[3];
}
DI void rope4(const f32x4 x1, const f32x4 x2, const f32x4 c01, const f32x4 c23, float sc, u32x2& o1, u32x2& o2) {
  const float y10 = (x1[0] * c01[0] - x2[0] * c01[1]) * sc, y20 = (x2[0] * c01[0] + x1[0] * c01[1]) * sc;
  const float y11 = (x1[1] * c01[2] - x2[1] * c01[3]) * sc, y21 = (x2[1] * c01[2] + x1[1] * c01[3]) * sc;
  const float y12 = (x1[2] * c23[0] - x2[2] * c23[1]) * sc, y22 = (x2[2] * c23[0] + x1[2] * c23[1]) * sc;
  const float y13 = (x1[3] * c23[2] - x2[3] * c23[3]) * sc, y23 = (x2[3] * c23[2] + x1[3] * c23[3]) * sc;
  o1.x = pack2(y10, y11); o1.y = pack2(y12, y13); o2.x = pack2(y20, y21); o2.y = pack2(y22, y23);
}
DI int dil_row(int row, int dsh) { const int s_ = row & (SEQ - 1); return (row & ~(SEQ - 1)) + ((s_ & ((1 << dsh) - 1)) << (13 - dsh)) + (s_ >> dsh); }
#define EPI_ROW(it_) (row0 + ((it_) >> 2) * 128 + ((it_) & 3) * 16)
#define EPI_LROW(it_) (wr * 64 + fr + ((it_) >> 2) * 128 + ((it_) & 3) * 16)

struct EpiP1 {
  static constexpr bool CARRY = false;
  char* ws;
  DI void operator()(f32x4 (&acc)[2][2][4][2], const GUnit& u, int wr, int wc, int fr, int fq, const LAS float* rst) const {
    asm volatile("" : "+v"(fr), "+v"(fq));
    u16* CQ = (u16*)(ws + OFF_CQ); u16* CKV = (u16*)(ws + OFF_CKV); u16* KROPE = (u16*)(ws + OFF_KROPE);
    u16* QKVB = (u16*)(ws + OFF_QKVB); u16* QKVC = (u16*)(ws + OFF_QKVC);
    float* RSQ = (float*)(ws + OFF_RSQ);
    const float2* cs64 = (const float2*)(ws + OFF_CS64);
    const float2* cs32 = (const float2*)(ws + OFF_CS32);
    const float QS = 0.125f * LOG2E;
    const int row0 = u.pm * 256 + wr * 64 + fr;
    const int pn = u.pn;
    float rsv[8];
#pragma unroll
    for (int it = 0; it < 8; ++it) rsv[it] = rst[EPI_LROW(it)];
    if (pn < 2) {
      const bool kr = (pn == 1) && (wc == 0);
      f32x4 c01 = {0.f, 0.f, 0.f, 0.f}, c23 = c01;
      if (kr) { const float2* cp = cs32 + (EPI_ROW(0) & (SEQ - 1)) * 16 + 4 * fq; c01 = *(const f32x4*)cp; c23 = *(const f32x4*)(cp + 2); }
#pragma unroll
      for (int it = 0; it < 8; ++it) {
        const int ai = it >> 2, m = it & 3;
        const int row = EPI_ROW(it);
        f32x4 n01 = c01, n23 = c23;
        if (kr && it + 1 < 8) { const float2* cp = cs32 + (EPI_ROW(it + 1) & (SEQ - 1)) * 16 + 4 * fq; n01 = *(const f32x4*)cp; n23 = *(const f32x4*)(cp + 2); }
        float ss = 0.f;
#pragma unroll
        for (int bj = 0; bj < 2; ++bj) {
          const f32x4 v0 = acc[ai][bj][m][0] * rsv[it], v1 = acc[ai][bj][m][1] * rsv[it];
          if (pn == 0) {
            *(u32x4*)(CQ + (size_t)row * 256 + bj * 128 + wc * 32 + 8 * fq) = pack8(v0, v1);
            ss += sumsq8(v0, v1);
          } else if (bj == 0) {
            *(u32x4*)(CKV + (size_t)row * 128 + wc * 32 + 8 * fq) = pack8(v0, v1);
            ss += sumsq8(v0, v1);
          } else if (wc == 0) {
            u32x2 o1, o2;
            rope4(v0, v1, c01, c23, 1.f, o1, o2);
            *(u32x2*)(KROPE + (size_t)row * 32 + 4 * fq) = o1;
            *(u32x2*)(KROPE + (size_t)row * 32 + 16 + 4 * fq) = o2;
          }
        }
        ss = xrows_sum(ss);
        if (fq == 0) ((float*)(ws + (pn == 0 ? OFF_PQ : OFF_PKV)))[(size_t)row * 4 + wc] = ss;
        c01 = n01; c23 = n23;
      }
    } else if (pn < 11) {
      const int tsel = (pn - 2) / 3;
      if (tsel < 2) {
        const int q = (wc & 1) * 4 + fq;
        const float sc = (tsel == 0) ? QS : 1.f;
        const float2* cp0 = cs64 + (EPI_ROW(0) & (SEQ - 1)) * 32 + 4 * q;
        f32x4 c01 = *(const f32x4*)cp0, c23 = *(const f32x4*)(cp0 + 2);
#pragma unroll
        for (int it = 0; it < 8; ++it) {
          const int ai = it >> 2, m = it & 3;
          const int row = EPI_ROW(it);
          f32x4 n01 = c01, n23 = c23;
          if (it + 1 < 8) { const float2* cp = cs64 + (EPI_ROW(it + 1) & (SEQ - 1)) * 32 + 4 * q; n01 = *(const f32x4*)cp; n23 = *(const f32x4*)(cp + 2); }
#pragma unroll
          for (int bj = 0; bj < 2; ++bj) {
            const int colg = (pn - 2) * 256 + bj * 128 + wc * 32;
            u32x2 o1, o2;
            rope4(acc[ai][bj][m][0], acc[ai][bj][m][1], c01, c23, sc * rsv[it], o1, o2);
            u16* d = QKVB + ((size_t)(colg >> 6) * T + dil_row(row, 2 * ((((colg >> 6) % 12)) >> 2))) * 64 + 4 * q;
            *(u32x2*)d = o1;
            *(u32x2*)(d + 32) = o2;
          }
          c01 = n01; c23 = n23;
        }
      } else {
#pragma unroll
        for (int it = 0; it < 8; ++it) {
          const int ai = it >> 2, m = it & 3;
          const int row = EPI_ROW(it);
#pragma unroll
          for (int bj = 0; bj < 2; ++bj) {
            const int colg = (pn - 2) * 256 + bj * 128 + wc * 32;
            *(u32x4*)(QKVB + ((size_t)(colg >> 6) * T + dil_row(row, 2 * ((((colg >> 6) % 12)) >> 2))) * 64 + (colg & 63) + 8 * fq) = pack8(acc[ai][bj][m][0] * rsv[it], acc[ai][bj][m][1] * rsv[it]);
          }
        }
      }
    } else {
      const float sc = (pn - 11 < 2) ? QS : 1.f;
#pragma unroll
      for (int it = 0; it < 8; ++it) {
        const int ai = it >> 2, m = it & 3;
        const int row = EPI_ROW(it);
#pragma unroll
        for (int bj = 0; bj < 2; ++bj) {
          const int cc = (pn - 11) * 256 + bj * 128 + wc * 32 + 8 * fq;
          *(u32x4*)(QKVC + ((size_t)(cc >> 6) * T + row) * 64 + (cc & 63)) = pack8(acc[ai][bj][m][0] * (sc * rsv[it]), acc[ai][bj][m][1] * (sc * rsv[it]));
        }
      }
    }
  }
};

struct EpiP2q {
  static constexpr bool CARRY = false;
  char* ws;
  DI void operator()(f32x4 (&acc)[2][2][4][2], const GUnit& u, int wr, int wc, int fr, int fq, const LAS float* rst) const {
    asm volatile("" : "+v"(fr), "+v"(fq));
    u16* QA = (u16*)(ws + OFF_QA);
    const float2* cs32 = (const float2*)(ws + OFF_CS32);
    const float QS = 0.10206207261596575f * LOG2E;
    const int row0 = u.pm * 256 + wr * 64 + fr;
    float rsv[8];
#pragma unroll
    for (int it = 0; it < 8; ++it) rsv[it] = rst[EPI_LROW(it)] * QS;
#pragma unroll
    for (int bj = 0; bj < 2; ++bj) {
      const int colg = u.pn * 256 + bj * 128 + wc * 32;
      const bool rope = (colg % 96) == 64;
      if (rope) {
        const float2* cp0 = cs32 + (EPI_ROW(0) & (SEQ - 1)) * 16 + 4 * fq;
        f32x4 c01 = *(const f32x4*)cp0, c23 = *(const f32x4*)(cp0 + 2);
#pragma unroll
        for (int it = 0; it < 8; ++it) {
          const int ai = it >> 2, m = it & 3;
          const int row = EPI_ROW(it);
          f32x4 n01 = c01, n23 = c23;
          if (it + 1 < 8) { const float2* cp = cs32 + (EPI_ROW(it + 1) & (SEQ - 1)) * 16 + 4 * fq; n01 = *(const f32x4*)cp; n23 = *(const f32x4*)(cp + 2); }
          u32x2 o1, o2;
          rope4(acc[ai][bj][m][0], acc[ai][bj][m][1], c01, c23, rsv[it], o1, o2);
          *(u32x2*)(QA + (size_t)row * 768 + colg + 4 * fq) = o1;
          *(u32x2*)(QA + (size_t)row * 768 + colg + 16 + 4 * fq) = o2;
          c01 = n01; c23 = n23;
        }
      } else {
#pragma unroll
        for (int it = 0; it < 8; ++it) {
          const int ai = it >> 2, m = it & 3;
          *(u32x4*)(QA + (size_t)EPI_ROW(it) * 768 + colg + 8 * fq) = pack8(acc[ai][bj][m][0] * rsv[it], acc[ai][bj][m][1] * rsv[it]);
        }
      }
    }
  }
};
struct EpiP2kv {
  static constexpr bool CARRY = false;
  char* ws;
  DI void operator()(f32x4 (&acc)[2][2][4][2], const GUnit& u, int wr, int wc, int fr, int fq, const LAS float* rst) const {
    asm volatile("" : "+v"(fr), "+v"(fq));
    u16* KVA = (u16*)(ws + OFF_KVA);
    const float* RSQ = (const float*)(ws + OFF_RSQ);
    const int row0 = u.pm * 256 + wr * 64 + fr;
    float rsv[8];
#pragma unroll
    for (int it = 0; it < 8; ++it) { const f32x4 q_ = ((const f32x4*)(ws + OFF_PKV))[EPI_ROW(it)]; rsv[it] = (q_[0] + q_[1]) + (q_[2] + q_[3]); }
#pragma unroll
    for (int it = 0; it < 8; ++it) {
      const int ai = it >> 2, m = it & 3;
      const int row = EPI_ROW(it);
      const float rs = rsqrtf(rsv[it] * (1.f / 128.f) + EPS);
#pragma unroll
      for (int bj = 0; bj < 2; ++bj)
        *(u32x4*)(KVA + (size_t)row * 1024 + u.pn * 256 + bj * 128 + wc * 32 + 8 * fq) = pack8(acc[ai][bj][m][0] * rs, acc[ai][bj][m][1] * rs);
    }
  }
};

DI unsigned char* gate_ptr(char* ws, int br, int row) {
  if (br == 0) return (unsigned char*)(ws + OFF_KVA) + (size_t)row * 2048;
  if (br == 1) return (unsigned char*)(ws + OFF_QKVB) + (size_t)12 * T * 128 + (size_t)row * 1024;
  return (unsigned char*)(ws + OFF_QKVC) + (size_t)8 * T * 128 + (size_t)row * 1024;
}
DI unsigned pack4_u8(const f32x4 v) {
  unsigned r = 0u;
  r = __builtin_amdgcn_cvt_pk_u8_f32(fmaxf(v[0] * 255.f, 0.51f), 0, r); r = __builtin_amdgcn_cvt_pk_u8_f32(fmaxf(v[1] * 255.f, 0.51f), 1, r);
  r = __builtin_amdgcn_cvt_pk_u8_f32(fmaxf(v[2] * 255.f, 0.51f), 2, r); r = __builtin_amdgcn_cvt_pk_u8_f32(fmaxf(v[3] * 255.f, 0.51f), 3, r);
  return r;
}
DI f32x4 unpack4_u8(unsigned r) {
  const float k = 1.f / 255.f;
  return (f32x4){(float)(r & 0xffu) * k, (float)((r >> 8) & 0xffu) * k, (float)((r >> 16) & 0xffu) * k, (float)(r >> 24) * k};
}
struct EpiGate {
  static constexpr bool CARRY = false;
  char* ws;
  DI void operator()(f32x4 (&acc)[2][2][4][2], const GUnit& u, int wr, int wc, int fr, int fq, const LAS float* rst) const {
    asm volatile("" : "+v"(fr), "+v"(fq));
    const int row0 = u.pm * 256 + wr * 64 + fr;
    const int br = u.pn >> 2;
    const float* RSQ = (const float*)(ws + OFF_RSQ);
    float rsv[8];
#pragma unroll
    for (int it = 0; it < 8; ++it) rsv[it] = rst[EPI_LROW(it)];
#pragma unroll
    for (int it = 0; it < 8; ++it) {
      const int ai = it >> 2, m = it & 3;
      const int row = EPI_ROW(it);
      unsigned char* g = gate_ptr(ws, br, row) + (u.pn & 3) * 256 + wc * 32 + 8 * fq;
      const float rs = rsv[it];
#pragma unroll
      for (int bj = 0; bj < 2; ++bj) {
        f32x4 v0 = acc[ai][bj][m][0] * rs, v1 = acc[ai][bj][m][1] * rs;
#pragma unroll
        for (int e = 0; e < 4; ++e) { v0[e] = sigmoidf_(v0[e]); v1[e] = sigmoidf_(v1[e]); }
        u32x2 gq; gq.x = pack4_u8(v0); gq.y = pack4_u8(v1);
        *(u32x2*)(g + bj * 128) = gq;
      }
    }
  }
};
struct EpiMerge {
  static constexpr bool CARRY = true;
  char* ws; u16* merged;
  DI void operator()(f32x4 (&acc)[2][2][4][2], const GUnit& u, int wr, int wc, int fr, int fq, const LAS float* rst) const {
    asm volatile("" : "+v"(fr), "+v"(fq));
    const int row0 = u.pm * 256 + wr * 64 + fr;
    const int br = u.tag;
    const int col = u.pn * 256 + wc * 32 + 8 * fq;
    const int brn = (br < 2) ? br + 1 : br;
    u32x2 a0, a1, b0, b1;
    {
      const unsigned char* g = gate_ptr(ws, br, EPI_ROW(0)) + col;
      a0 = *(const u32x2*)g; a1 = *(const u32x2*)(g + 128);
      const unsigned char* gn = gate_ptr(ws, brn, EPI_ROW(0)) + col;
      b0 = *(const u32x2*)gn; b1 = *(const u32x2*)(gn + 128);
    }
#pragma unroll
    for (int it = 0; it < 8; ++it) {
      const int ai = it >> 2, m = it & 3;
      const int row = EPI_ROW(it);
      u32x2 na0 = a0, na1 = a1, nb0 = b0, nb1 = b1;
      if (it + 1 < 8) {
        const unsigned char* g = gate_ptr(ws, br, EPI_ROW(it + 1)) + col;
        na0 = *(const u32x2*)g; na1 = *(const u32x2*)(g + 128);
        const unsigned char* gn = gate_ptr(ws, brn, EPI_ROW(it + 1)) + col;
        nb0 = *(const u32x2*)gn; nb1 = *(const u32x2*)(gn + 128);
      }
#pragma unroll
      for (int bj = 0; bj < 2; ++bj) {
        const u32x2 ga = bj ? a1 : a0;
        const u32x2 gb = bj ? b1 : b0;
        f32x4 f0 = unpack4_u8(ga.x), f1 = unpack4_u8(ga.y);
        if (br < 2) {
          const f32x4 d0 = unpack4_u8(gb.x), d1 = unpack4_u8(gb.y);
#pragma unroll
          for (int e = 0; e < 4; ++e) { f0[e] *= __builtin_amdgcn_rcpf(d0[e]); f1[e] *= __builtin_amdgcn_rcpf(d1[e]); }
          acc[ai][bj][m][0] *= f0; acc[ai][bj][m][1] *= f1;
        } else {
          *(u32x4*)(merged + (size_t)row * 1024 + col + bj * 128) = pack8(acc[ai][bj][m][0] * f0, acc[ai][bj][m][1] * f1);
        }
      }
      a0 = na0; a1 = na1; b0 = nb0; b1 = nb1;
    }
  }
};
struct SchedMerge {
  char* ws; int G, c;
  DI bool next(int i, GUnit& u) const {
    const int tile = i / 3, br = i - tile * 3;
    const int L = tile * G + c;
    if (L >= 512) return false;
    static_tile(L, 128, 4, u.pm, u.pn);
    u.tag = br;
    if (br == 0) { u.A = ws + OFF_QA + (size_t)u.pm * 256 * 768 * 2; u.lda = 768; u.akb = 192; u.nt = 8; u.B = ws + OFF_W + (W_PA + (size_t)u.pn * 256 * 512) * 2; }
    else if (br == 1) { u.A = ws + OFF_CQ + (size_t)u.pm * 256 * 256 * 2; u.lda = 256; u.akb = 128; u.nt = 4; u.B = ws + OFF_W + (W_PB + (size_t)u.pn * 256 * 256) * 2; }
    else { u.A = ws + OFF_QKVC + (size_t)u.pm * 256 * 64 * 2; u.lda = 64; u.akb = T * 128; u.nt = 8; u.B = ws + OFF_W + (W_PC + (size_t)u.pn * 256 * 512) * 2; }
    return true;
  }
};
struct EpiResid {
  static constexpr bool CARRY = false;
  const float* xin32; const u16* xin16; float* xout; u16* x16; float* rowsq;
  DI void operator()(f32x4 (&acc)[2][2][4][2], const GUnit& u, int wr, int wc, int fr, int fq, const LAS float* rst) const {
    asm volatile("" : "+v"(fr), "+v"(fq));
    const int row0 = u.pm * 256 + wr * 64 + fr, col0 = u.pn * 256 + wc * 32 + 4 * fq;
    f32x4 b[2][2];
#define RESID_LOAD(dst_, it_) do { const size_t o_ = (size_t)EPI_ROW(it_) * 1024 + col0; \
      _Pragma("unroll") for (int bj = 0; bj < 2; ++bj) _Pragma("unroll") for (int n = 0; n < 2; ++n) { \
        if (xin32) dst_[bj][n] = *(const f32x4*)(xin32 + o_ + bj * 128 + n * 16); \
        else { const u32x2 h_ = *(const u32x2*)(xin16 + o_ + bj * 128 + n * 16); dst_[bj][n] = (f32x4){bflo(h_.x), bfhi(h_.x), bflo(h_.y), bfhi(h_.y)}; } } } while (0)
    RESID_LOAD(b, 0);
#pragma unroll
    for (int it = 0; it < 8; ++it) {
      const int ai = it >> 2, m = it & 3;
      const int row = EPI_ROW(it);
      f32x4 nb[2][2];
#pragma unroll
      for (int bj = 0; bj < 2; ++bj)
#pragma unroll
        for (int n = 0; n < 2; ++n) nb[bj][n] = b[bj][n];
      if (it + 1 < 8) RESID_LOAD(nb, it + 1);
      const size_t off = (size_t)row * 1024 + col0;
      float ss = 0.f;
#pragma unroll
      for (int bj = 0; bj < 2; ++bj)
#pragma unroll
        for (int n = 0; n < 2; ++n) {
          const f32x4 v = b[bj][n] + acc[ai][bj][m][n];
          if (xout) *(f32x4*)(xout + off + bj * 128 + n * 16) = v;
          if (x16) { u32x2 o; o.x = pack2(v[0], v[1]); o.y = pack2(v[2], v[3]); *(u32x2*)(x16 + off + bj * 128 + n * 16) = o; }
          ss += v[0] * v[0] + v[1] * v[1] + v[2] * v[2] + v[3] * v[3];
        }
      ss = xrows_sum(ss);
      if (fq == 0) rowsq[(size_t)row * 16 + u.pn * 4 + wc] = ss;
#pragma unroll
      for (int bj = 0; bj < 2; ++bj)
#pragma unroll
        for (int n = 0; n < 2; ++n) b[bj][n] = nb[bj][n];
    }
#undef RESID_LOAD
  }
};
struct EpiNull {
  static constexpr bool CARRY = false;
  DI void operator()(f32x4 (&acc)[2][2][4][2], const GUnit& u, int wr, int wc, int fr, int fq, const LAS float* rst) const {
    if (acc[0][0][0][0][0] == 123456.789f) *(volatile float*)nullptr = acc[1][1][3][1][3];
  }
};
struct EpiFFN {
  static constexpr bool CARRY = false;
  char* ws;
  DI void operator()(f32x4 (&acc)[2][2][4][2], const GUnit& u, int wr, int wc, int fr, int fq, const LAS float* rst) const {
    asm volatile("" : "+v"(fr), "+v"(fq));
    u16* HID = (u16*)(ws + OFF_QKVB);
    const float* RSQ = (const float*)(ws + OFF_RSQ);
    const int row0 = u.pm * 256 + wr * 64 + fr, col0 = u.pn * 128 + wc * 32 + 8 * fq;
    float rsv[8];
#pragma unroll
    for (int it = 0; it < 8; ++it) rsv[it] = rst[EPI_LROW(it)];
#pragma unroll
    for (int it = 0; it < 8; ++it) {
      const int ai = it >> 2, m = it & 3;
      const float rs = rsv[it];
      f32x4 v[2];
#pragma unroll
      for (int n = 0; n < 2; ++n)
#pragma unroll
        for (int e = 0; e < 4; ++e) { const float a1 = acc[ai][0][m][n][e] * rs; v[n][e] = a1 * sigmoidf_(a1) * (acc[ai][1][m][n][e] * rs); }
#ifdef NT_STORE
      __builtin_nontemporal_store(pack8(v[0], v[1]), (u32x4*)(HID + (size_t)EPI_ROW(it) * 2816 + col0));
#else
      *(u32x4*)(HID + (size_t)EPI_ROW(it) * 2816 + col0) = pack8(v[0], v[1]);
#endif
    }
  }
};


struct EpiFFN_NoLoad {
  char* ws;
  DI void operator()(f32x4 (&acc)[2][2][4][2], const GUnit& u, int wr, int wc, int fr, int fq, const LAS float* rst) const {
    asm volatile("" : "+v"(fr), "+v"(fq));
    u16* HID = (u16*)(ws + OFF_QKVB);
    const int row0 = u.pm * 256 + wr * 64 + fr, col0 = u.pn * 128 + wc * 32 + 8 * fq;
#pragma unroll
    for (int it = 0; it < 8; ++it) {
      const int ai = it >> 2, m = it & 3;
#ifdef PROBE_HALFSTORE
      if (it & 1) continue;
#endif
#ifdef PROBE_TILED
      { const int r_ = EPI_ROW(it), c_ = u.pn * 128 + wc * 32; *(u32x4*)(HID + ((size_t)(r_ >> 4) * 88 + (c_ >> 5)) * 512 + (r_ & 15) * 32 + 8 * fq) = pack8(acc[ai][0][m][0] * acc[ai][1][m][0], acc[ai][0][m][1] * acc[ai][1][m][1]); }
#else
      *(u32x4*)(HID + (size_t)EPI_ROW(it) * 2816 + col0) = pack8(acc[ai][0][m][0] * acc[ai][1][m][0], acc[ai][0][m][1] * acc[ai][1][m][1]);
#endif
    }
  }
};

template <int MODE>
DI void attn_block(const Params& p, int l, int bidx, u16* sm, float* smf_all, u16* oalt = nullptr) {
  constexpr int DQK = (MODE == 0) ? 96 : 64;
  constexpr int KS = DQK / 16, KLD = DQK + 8, VLD = 96;
  constexpr int STG = 64 * KLD + 64 * VLD;
  constexpr int NRK = 2;
  const int t = tid_l(), lane = t & 63, w = t >> 6, l32 = lane & 31, hh = lane >> 5;
  const int half = (MODE == 0) ? 0 : (w >> 2);
  const int wl = (MODE == 0) ? w : (w & 3);
  const int tl = (MODE == 0) ? t : (t & 255);
  const int idx = (MODE == 0) ? bidx : (2 * bidx + half);
  u16* sreg = sm + half * 2 * STG;
  float* smf = smf_all + half * 512;
  char* ws = ptr_l(p.ws);
  const int kk = (MODE == 0) ? (t >> 3) : (tl >> 3);
  const int cx = (MODE == 0) ? (t & 7) : (tl & 7);
  int b, ntiles, NTL;
  u16* qptr;
  int h = 0, g = 0, hh4 = 0, dsh = 0, r = 0, mk0 = 0, L = 0, mq = 0, mq0w = 0;
  int rs0 = 0, qrow = 0, qc = 0, rsq = 0, csq = 0;
  size_t qtok;
  if (MODE == 0) {
    const int qblk = idx & 31; h = (idx >> 5) & 7; b = idx >> 8;
    qtok = (size_t)b * SEQ + qblk * 256 + w * 32 + l32;
    qptr = (u16*)(ws + OFF_QA) + qtok * 768 + h * 96;
    ntiles = 128; NTL = 128;
  } else if (MODE == 1) {
    const int sub = idx & 63; hh4 = (idx >> 6) & 3; g = (idx >> 8) % 3; b = idx / 768;
    dsh = 2 * g; L = SEQ >> dsh;
    const int nqb_sh = 6 - dsh;
    r = sub >> nqb_sh;
    const int qb = sub & ((1 << nqb_sh) - 1);
    h = g * 4 + hh4;
    mq0w = qb * 128 + wl * 32;
    mq = mq0w + l32;
    mk0 = qb * 128 - 64;
    qtok = (size_t)b * SEQ + ((size_t)mq << dsh) + r;
    qptr = (u16*)(ws + OFF_QKVB) + ((size_t)h * T + (size_t)b * SEQ + (size_t)r * L + mq) * 64;
    ntiles = 4; NTL = 4;
  } else {
    const int rp = idx & 63; h = (idx >> 6) & 7; b = idx >> 9;
    qrow = 2 * rp + (wl >> 1); qc = (wl & 1) * 32 + l32;
    qtok = (size_t)b * SEQ + qrow * 64 + qc;
    qptr = (u16*)(ws + OFF_QKVC) + ((size_t)h * T + qtok) * 64;
    rs0 = min(max(2 * rp - 4, 0), 120);
    const int rs1 = min(max(2 * rp + 1 - 4, 0), 120);
    ntiles = rs1 + 8 - rs0; NTL = 9;
    rsq = min(max(qrow - 4, 0), 120);
    csq = min(max(qc - 8, 0), 48);
  }
  float* tb = (float*)((char*)sm + 90112 + half * 8192);
  if (MODE == 2) {
    const float* rp_ = p.rpb + (size_t)(l * 8 + h) * 465;
    for (int i = tl; i < 465; i += 256) { const int r_ = i / 31, j_ = i - r_ * 31; tb[r_ * 128 + 49 + j_] = rp_[i] * LOG2E; }
  }
  bf16x8 qf[KS];
#pragma unroll
  for (int ks = 0; ks < KS; ++ks) qf[ks] = *(const bf16x8*)(qptr + ks * 16 + hh * 8);

  constexpr int NTLC = (MODE == 1) ? 4 : 9;
  u32x4 st_[2][4], x_[4];
#define LOAD_TILE(tt_, D_) do { \
    if (MODE == 1) { \
      int mka_ = mk0 + (tt_) * 64 + kk, mkb_ = mka_ + 32; mka_ = min(max(mka_, 0), L - 1); mkb_ = min(max(mkb_, 0), L - 1); \
      const u16* ba_ = (const u16*)(ws + OFF_QKVB) + ((size_t)(12 + h) * T + (size_t)b * SEQ + (size_t)r * L + mka_) * 64 + cx * 8; \
      const u16* bb_ = (const u16*)(ws + OFF_QKVB) + ((size_t)(12 + h) * T + (size_t)b * SEQ + (size_t)r * L + mkb_) * 64 + cx * 8; \
      D_[0] = *(const u32x4*)(ba_); D_[1] = *(const u32x4*)(bb_); \
      D_[2] = *(const u32x4*)(ba_ + (size_t)12 * T * 64); D_[3] = *(const u32x4*)(bb_ + (size_t)12 * T * 64); \
    } else { \
      const u16* ba_ = (const u16*)(ws + OFF_QKVC) + ((size_t)(8 + h) * T + (size_t)b * SEQ + (rs0 + min((tt_), ntiles - 1)) * 64 + kk) * 64 + cx * 8; \
      D_[0] = *(const u32x4*)(ba_); D_[1] = *(const u32x4*)(ba_ + 32 * 64); \
      D_[2] = *(const u32x4*)(ba_ + (size_t)8 * T * 64); D_[3] = *(const u32x4*)(ba_ + (size_t)8 * T * 64 + 32 * 64); \
    } } while (0)
#define STORE_TILE(stg_, S_) do { \
    u16* sK_ = sreg + (stg_) * STG; u16* sV_ = sK_ + 64 * KLD; \
    *(u32x4*)(sK_ + kk * KLD + cx * 8) = S_[0]; *(u32x4*)(sK_ + (kk + 32) * KLD + cx * 8) = S_[1]; \
    *(u32x4*)(sV_ + kk * VLD + cx * 8) = S_[2]; *(u32x4*)(sV_ + (kk + 32) * VLD + cx * 8) = S_[3]; } while (0)
  LOAD_TILE(0, x_); LOAD_TILE(1, st_[0]); LOAD_TILE(2, st_[1]);
  STORE_TILE(0, x_);
  __syncthreads();

  f32x16 o[2];
#pragma unroll
  for (int i = 0; i < 16; ++i) { o[0][i] = 0.f; o[1][i] = 0.f; }
  float m_run = -1e30f, l_run = 0.f;
  const int li = lane & 15, qd = li >> 2, pp = li & 3, dblk = (lane >> 4) & 1;
  const int voff = (4 * hh + qd) * VLD + 16 * dblk + 4 * pp;

#pragma unroll
  for (int tt = 0; tt < NTLC; ++tt) {
    if (tt + 1 < NTLC) { STORE_TILE((tt + 1) & 1, st_[tt % 2]); if (tt + 3 < NTLC) LOAD_TILE(tt + 3, st_[tt % 2]); }
    const u16* sK = sreg + (tt & 1) * STG;
    const u16* sV = sK + 64 * KLD;
    bool active = true;
    if (MODE == 1) {
      const int klo = mk0 + tt * 64;
      active = !(klo + 63 < mq0w - 64 || klo > mq0w + 95);
    } else if (MODE == 2) {
      const int krow = rs0 + tt;
      active = (krow >= rsq) && (krow < rsq + 8);
    }
    if (active) {
      f32x16 s[2];
      bf16x8 kf[KS][2];
#pragma unroll
      for (int ks = 0; ks < KS; ++ks)
#pragma unroll
        for (int k2 = 0; k2 < 2; ++k2) kf[ks][k2] = *(const bf16x8*)(sK + (k2 * 32 + l32) * KLD + ks * 16 + hh * 8);
      s16x4 vlo[2][2][2], vhi[2][2][2];
#pragma unroll
      for (int k2 = 0; k2 < 2; ++k2)
#pragma unroll
        for (int s2 = 0; s2 < 2; ++s2)
#pragma unroll
          for (int dt = 0; dt < 2; ++dt) {
            const u16* va = sV + (k2 * 32 + 16 * s2) * VLD + voff + dt * 32;
            vlo[k2][s2][dt] = __builtin_amdgcn_ds_read_tr16_b64_v4i16((s16x4 LAS*)(va));
            vhi[k2][s2][dt] = __builtin_amdgcn_ds_read_tr16_b64_v4i16((s16x4 LAS*)(va + 8 * VLD));
          }
#pragma unroll
      for (int k2 = 0; k2 < 2; ++k2)
#pragma unroll
        for (int i = 0; i < 16; ++i) s[k2][i] = 0.f;
#pragma unroll
      for (int ks = 0; ks < KS; ++ks)
#pragma unroll
        for (int k2 = 0; k2 < 2; ++k2) s[k2] = MFMA(kf[ks][k2], qf[ks], s[k2]);
      if (MODE == 1) {
        const int klo = mk0 + tt * 64;
        const int db = klo + 4 * hh - mq + 64;
        const bool edge = (klo < 0) || (klo + 63 >= L);
        if (!edge) {
#pragma unroll
          for (int k2 = 0; k2 < 2; ++k2)
#pragma unroll
            for (int i = 0; i < 16; ++i) {
              const int ci = k2 * 32 + (i & 3) + 8 * (i >> 2);
              s[k2][i] = ((unsigned)(db + ci) <= 128u) ? s[k2][i] : -INFINITY;
            }
        } else {
          const int mb = klo + 4 * hh;
#pragma unroll
          for (int k2 = 0; k2 < 2; ++k2)
#pragma unroll
            for (int i = 0; i < 16; ++i) {
              const int ci = k2 * 32 + (i & 3) + 8 * (i >> 2);
              const bool valid = ((unsigned)(db + ci) <= 128u) && ((unsigned)(mb + ci) < (unsigned)L);
              s[k2][i] = valid ? s[k2][i] : -INFINITY;
            }
        }
      } else if (MODE == 2) {
        const float* tp = tb + (rs0 + tt - qrow + 7) * 128 + 64 + 4 * hh - qc;
        const int e0 = 4 * hh - csq;
        float bv[2][16];
#pragma unroll
        for (int k2 = 0; k2 < 2; ++k2)
#pragma unroll
          for (int i = 0; i < 16; ++i) bv[k2][i] = tp[k2 * 32 + (i & 3) + 8 * (i >> 2)];
#pragma unroll
        for (int k2 = 0; k2 < 2; ++k2)
#pragma unroll
          for (int i = 0; i < 16; ++i) {
            const int ci = k2 * 32 + (i & 3) + 8 * (i >> 2);
            const float sb = s[k2][i] + bv[k2][i];
            s[k2][i] = ((unsigned)(ci + e0) < 16u) ? sb : -INFINITY;
          }
      }
      float mx = s[0][0];
#pragma unroll
      for (int i = 1; i < 16; ++i) mx = fmaxf(mx, s[0][i]);
#pragma unroll
      for (int i = 0; i < 16; ++i) mx = fmaxf(mx, s[1][i]);
      mx = xhalf_max(mx);
      const float mnew = fmaxf(m_run, mx);
      const float alpha = __builtin_amdgcn_exp2f(m_run - mnew);
      m_run = mnew;
      float ps = 0.f;
#pragma unroll
      for (int k2 = 0; k2 < 2; ++k2)
#pragma unroll
        for (int i = 0; i < 16; ++i) { s[k2][i] = __builtin_amdgcn_exp2f(s[k2][i] - mnew); ps += s[k2][i]; }
      l_run = l_run * alpha + ps;
#pragma unroll
      for (int i = 0; i < 16; ++i) { o[0][i] *= alpha; o[1][i] *= alpha; }
#pragma unroll
      for (int k2 = 0; k2 < 2; ++k2)
#pragma unroll
        for (int s2 = 0; s2 < 2; ++s2) {
          u32x4 u;
          u.x = pack2(s[k2][8 * s2 + 0], s[k2][8 * s2 + 1]); u.y = pack2(s[k2][8 * s2 + 2], s[k2][8 * s2 + 3]);
          u.z = pack2(s[k2][8 * s2 + 4], s[k2][8 * s2 + 5]); u.w = pack2(s[k2][8 * s2 + 6], s[k2][8 * s2 + 7]);
          const bf16x8 pf = __builtin_bit_cast(bf16x8, u);
#pragma unroll
          for (int dt = 0; dt < 2; ++dt) {
            const bf16x8 vf = __builtin_shufflevector(vlo[k2][s2][dt], vhi[k2][s2][dt], 0, 1, 2, 3, 4, 5, 6, 7);
            o[dt] = MFMA(vf, pf, o[dt]);
          }
        }
    }
    __syncthreads();
  }
#undef LOAD_TILE
#undef STORE_TILE
  const float l_tot = xhalf_sum(l_run);
  const float inv = __builtin_amdgcn_rcpf(l_tot);
  {
    u16* op_ = !oalt ? qptr : (MODE == 0 ? (oalt + qtok * 768 + h * 96) : (MODE == 1 ? (oalt + qtok * 768 + h * 64) : (oalt + (size_t)T * 768 + qtok * 512 + h * 64)));
#pragma unroll
    for (int dt = 0; dt < 2; ++dt)
#pragma unroll
      for (int k = 0; k < 2; ++k) {
        u32x2 x, y;
        x.x = pack2(o[dt][8 * k] * inv, o[dt][8 * k + 1] * inv); x.y = pack2(o[dt][8 * k + 2] * inv, o[dt][8 * k + 3] * inv);
        y.x = pack2(o[dt][8 * k + 4] * inv, o[dt][8 * k + 5] * inv); y.y = pack2(o[dt][8 * k + 6] * inv, o[dt][8 * k + 7] * inv);
        *(u32x4*)(op_ + dt * 32 + 8 * (2 * k + hh)) = widen_pair(x, y);
      }
  }
  if (MODE == 1) {
    if (hh == 0) {
      float* LB = (float*)(ws + OFF_CKV);
      LB[((size_t)g * T + qtok) * 4 + hh4] = m_run * LN2 + __logf(l_tot);
    }
  }
}

#ifndef MLA_THR
#define MLA_THR 8.f
#endif
DI void attn_mla(const Params& p, int idx, u16* sm, u16* oalt) {
  constexpr int KS = 6, KLD = 104, VLD = 96, NTL = 128, KST = 64 * KLD, VST = 64 * VLD;
  u16* sKr = sm;
  u16* sVr = sm + 4 * KST;
  const int t = tid_l(), lane = t & 63, w = t >> 6, l32 = lane & 31, hh = lane >> 5;
  char* ws = ptr_l(p.ws);
  const int kk = t >> 3, cx = t & 7;
  const int qblk = idx & 31, h = (idx >> 5) & 7, b = idx >> 8;
  const size_t qtok = (size_t)b * SEQ + qblk * 256 + w * 32 + l32;
  u16* qptr = (u16*)(ws + OFF_QA) + qtok * 768 + h * 96;
  bf16x8 qf[KS];
#pragma unroll
  for (int ks = 0; ks < KS; ++ks) qf[ks] = *(const bf16x8*)(qptr + ks * 16 + hh * 8);
  const u16* kvbase = (const u16*)(ws + OFF_KVA) + ((size_t)b * SEQ + kk) * 1024 + h * 128;
  const u16* krbase = (const u16*)(ws + OFF_KROPE) + ((size_t)b * SEQ + kk) * 32;
#define MLA_LD(tk_, tv_, k0_, k1_, v0_) do { \
    k0_ = *(const u32x4*)(kvbase + (size_t)(tk_) * 64 * 1024 + cx * 8); \
    k1_ = *(const u32x4*)(krbase + (size_t)(tk_) * 64 * 32 + (cx & 3) * 8); \
    v0_ = *(const u32x4*)(kvbase + (size_t)(tv_) * 64 * 1024 + 64 + cx * 8); } while (0)
#define MLA_STK(sk_, k0_, k1_) do { u16* sK_ = sKr + (sk_) * KST; \
    *(u32x4*)(sK_ + kk * KLD + cx * 8) = k0_; \
    *(u32x4*)(sK_ + kk * KLD + 64 + (cx & 3) * 8) = k1_; } while (0)
#define MLA_STV(sv_, v0_) do { *(u32x4*)(sVr + (sv_) * VST + kk * VLD + cx * 8) = v0_; } while (0)
  u32x4 ck0, ck1, cv0, nk0, nk1, nv0;
  {
    u32x4 a0, a1, a2, b0, b1, b2;
    MLA_LD(0, 0, a0, a1, a2); MLA_LD(1, 1, b0, b1, cv0); MLA_LD(2, 1, nk0, nk1, b2); MLA_LD(3, 1, ck0, ck1, nv0);
    MLA_STK(0, a0, a1); MLA_STV(0, a2); MLA_STK(1, b0, b1); MLA_STK(2, nk0, nk1);
    unsigned zz = 0u; asm volatile("" : "+v"(zz));
    MLA_STV(3, ((u32x4){zz, zz, zz, zz}));
  }
  __syncthreads();
  const int li = lane & 15, qd = li >> 2, pp_ = li & 3, dblk = (lane >> 4) & 1;
  const int voff = (4 * hh + qd) * VLD + 16 * dblk + 4 * pp_;
  const int koff = l32 * KLD + hh * 8;
  f32x16 o[2], sA[2], sB[2], mneg;
#pragma unroll
  for (int i = 0; i < 16; ++i) { o[0][i] = 0.f; o[1][i] = 0.f; sA[0][i] = 0.f; sA[1][i] = 0.f; }
#pragma unroll
  for (int ks = 0; ks < KS; ++ks)
#pragma unroll
    for (int k2 = 0; k2 < 2; ++k2) sA[k2] = MFMA(*(const bf16x8*)(sKr + k2 * 32 * KLD + koff + ks * 16), qf[ks], sA[k2]);
  float m_run, l_run = 0.f;
  {
    float mx = sA[0][0];
#pragma unroll
    for (int i = 1; i < 16; ++i) mx = fmaxf(mx, sA[0][i]);
#pragma unroll
    for (int i = 0; i < 16; ++i) mx = fmaxf(mx, sA[1][i]);
    mx = xhalf_max(mx);
    m_run = mx;
#pragma unroll
    for (int i = 0; i < 16; ++i) { sA[0][i] -= mx; sA[1][i] -= mx; mneg[i] = -mx; }
  }
  bf16x8 pp[4];
#pragma unroll
  for (int i = 0; i < 4; ++i) { unsigned zq = 0u; asm volatile("" : "+v"(zq)); pp[i] = __builtin_bit_cast(bf16x8, ((u32x4){zq, zq, zq, zq})); }

#define MLA_BODY(tt, SIN, SOUT, LK0, LK1, LV0, SK0, SK1, SV0) do { \
    { const int tk_ = min((tt) + 4, NTL - 1), tv_ = min((tt) + 2, NTL - 1); MLA_LD(tk_, tv_, LK0, LK1, LV0); } \
    float mx = SIN[0][0]; \
    _Pragma("unroll") for (int i = 1; i < 16; ++i) mx = fmaxf(mx, SIN[0][i]); \
    _Pragma("unroll") for (int i = 0; i < 16; ++i) mx = fmaxf(mx, SIN[1][i]); \
    mx = xhalf_max(mx); \
    if (!__all(mx <= MLA_THR)) { \
      const float dm = fmaxf(mx, 0.f); \
      const float alpha = __builtin_amdgcn_exp2f(-dm); \
      m_run += dm; l_run *= alpha; \
      _Pragma("unroll") for (int i = 0; i < 16; ++i) { o[0][i] *= alpha; o[1][i] *= alpha; SIN[0][i] -= dm; SIN[1][i] -= dm; mneg[i] = -m_run; } \
      _Pragma("unroll") for (int q_ = 0; q_ < 4; ++q_) { \
        u32x4 u_ = __builtin_bit_cast(u32x4, pp[q_]); \
        u_.x = pack2(bflo(u_.x) * alpha, bfhi(u_.x) * alpha); u_.y = pack2(bflo(u_.y) * alpha, bfhi(u_.y) * alpha); \
        u_.z = pack2(bflo(u_.z) * alpha, bfhi(u_.z) * alpha); u_.w = pack2(bflo(u_.w) * alpha, bfhi(u_.w) * alpha); \
        pp[q_] = __builtin_bit_cast(bf16x8, u_); } \
    } \
    const u16* sK = sKr + (((tt) + 1) & 3) * KST + koff; \
    const u16* sV = sVr + (((tt) + 3) & 3) * VST + voff; \
    _Pragma("unroll") for (int k2 = 0; k2 < 2; ++k2) \
      _Pragma("unroll") for (int s2 = 0; s2 < 2; ++s2) \
        _Pragma("unroll") for (int dt = 0; dt < 2; ++dt) { \
          const u16* va = sV + (k2 * 32 + 16 * s2) * VLD + dt * 32; \
          const s16x4 lo = __builtin_amdgcn_ds_read_tr16_b64_v4i16((s16x4 LAS*)(va)); \
          const s16x4 hi = __builtin_amdgcn_ds_read_tr16_b64_v4i16((s16x4 LAS*)(va + 8 * VLD)); \
          o[dt] = MFMA(__builtin_shufflevector(lo, hi, 0, 1, 2, 3, 4, 5, 6, 7), pp[k2 * 2 + s2], o[dt]); \
        } \
    _Pragma("unroll") for (int k2 = 0; k2 < 2; ++k2) SOUT[k2] = MFMA(*(const bf16x8*)(sK + k2 * 32 * KLD), qf[0], mneg); \
    _Pragma("unroll") for (int ks = 1; ks < KS; ++ks) \
      _Pragma("unroll") for (int k2 = 0; k2 < 2; ++k2) SOUT[k2] = MFMA(*(const bf16x8*)(sK + k2 * 32 * KLD + ks * 16), qf[ks], SOUT[k2]); \
    float ps = 0.f; \
    _Pragma("unroll") for (int k2 = 0; k2 < 2; ++k2) \
      _Pragma("unroll") for (int i = 0; i < 16; ++i) { SIN[k2][i] = __builtin_amdgcn_exp2f(SIN[k2][i]); ps += SIN[k2][i]; } \
    l_run += ps; \
    _Pragma("unroll") for (int k2 = 0; k2 < 2; ++k2) \
      _Pragma("unroll") for (int s2 = 0; s2 < 2; ++s2) { \
        u32x4 u_; \
        u_.x = pack2(SIN[k2][8 * s2 + 0], SIN[k2][8 * s2 + 1]); u_.y = pack2(SIN[k2][8 * s2 + 2], SIN[k2][8 * s2 + 3]); \
        u_.z = pack2(SIN[k2][8 * s2 + 4], SIN[k2][8 * s2 + 5]); u_.w = pack2(SIN[k2][8 * s2 + 6], SIN[k2][8 * s2 + 7]); \
        pp[k2 * 2 + s2] = __builtin_bit_cast(bf16x8, u_); } \
    MLA_STK(((tt) + 3) & 3, SK0, SK1); MLA_STV(((tt) + 1) & 3, SV0); \
    __builtin_amdgcn_sched_group_barrier(0x100, 4, 0); \
    _Pragma("unroll") for (int g_ = 0; g_ < 20; ++g_) { __builtin_amdgcn_sched_group_barrier(0x008, 1, 0); __builtin_amdgcn_sched_group_barrier(0x100, 2, 0); __builtin_amdgcn_sched_group_barrier(0x402, 5, 0); } \
    __syncthreads(); \
  } while (0)
  for (int t2 = 0; t2 < NTL; t2 += 2) {
    MLA_BODY(t2, sA, sB, nk0, nk1, nv0, ck0, ck1, cv0);
    MLA_BODY(t2 + 1, sB, sA, ck0, ck1, cv0, nk0, nk1, nv0);
  }
#undef MLA_BODY
#undef MLA_LD
#undef MLA_STK
#undef MLA_STV
  {
    const u16* sV = sVr + 3 * VST + voff;
#pragma unroll
    for (int k2 = 0; k2 < 2; ++k2)
#pragma unroll
      for (int s2 = 0; s2 < 2; ++s2)
#pragma unroll
        for (int dt = 0; dt < 2; ++dt) {
          const u16* va = sV + (k2 * 32 + 16 * s2) * VLD + dt * 32;
          const s16x4 lo = __builtin_amdgcn_ds_read_tr16_b64_v4i16((s16x4 LAS*)(va));
          const s16x4 hi = __builtin_amdgcn_ds_read_tr16_b64_v4i16((s16x4 LAS*)(va + 8 * VLD));
          o[dt] = MFMA(__builtin_shufflevector(lo, hi, 0, 1, 2, 3, 4, 5, 6, 7), pp[k2 * 2 + s2], o[dt]);
        }
  }
  __syncthreads();
  const float l_tot = xhalf_sum(l_run);
  const float inv = __builtin_amdgcn_rcpf(l_tot);
  u16* op_ = oalt ? (oalt + qtok * 768 + h * 96) : qptr;
#pragma unroll
  for (int dt = 0; dt < 2; ++dt)
#pragma unroll
    for (int k = 0; k < 2; ++k) {
      u32x2 x, y;
      x.x = pack2(o[dt][8 * k] * inv, o[dt][8 * k + 1] * inv); x.y = pack2(o[dt][8 * k + 2] * inv, o[dt][8 * k + 3] * inv);
      y.x = pack2(o[dt][8 * k + 4] * inv, o[dt][8 * k + 5] * inv); y.y = pack2(o[dt][8 * k + 6] * inv, o[dt][8 * k + 7] * inv);
      *(u32x4*)(op_ + dt * 32 + 8 * (2 * k + hh)) = widen_pair(x, y);
    }
}

DI void phase_attn(const Params& p, int l, u16* sm, float* smf, int probe = 0) {
#ifdef ATTN_TRUE_XCC
  const int G = gdim_l(), bid = bid_l();
#else
  int bid = blockIdx.x; asm volatile("" : "+s"(bid));
  const int G = gdim_l();
#endif
  {
    const int x = bid & 7, G8 = G >> 3;
    if (probe != 2) for (int j = bid >> 3; j < 128; j += G8) {
      const int pair = x * 4 + (j >> 5);
      attn_mla(p, pair * 32 + (j & 31), sm, probe ? (u16*)p.out : nullptr);
    }
  }
  if (probe == 1) return;
  for (int bi = bid; bi < 1536 + 1024; bi += G) {
    if (bi < 1536) attn_block<1>(p, l, bi, sm, smf, probe ? (u16*)p.out : nullptr);
    else attn_block<2>(p, l, bi - 1536, sm, smf, probe ? (u16*)p.out : nullptr);
  }
}

DI void phase_dilmerge(const Params& p) {
  char* ws = ptr_l(p.ws);
  const u16* QKVB = (const u16*)(ws + OFF_QKVB);
  const float* LB = (const float*)(ws + OFF_CKV);
  u16* YB = (u16*)(ws + OFF_CQ);
  const int stride = gdim_l() * NT;
  for (int i = bid_l() * NT + tid_l(); i < T * 32; i += stride) {
    const int tok = i >> 5, c = i & 31, hh4 = c >> 3;
    float ls[3];
#pragma unroll
    for (int g = 0; g < 3; ++g) ls[g] = LB[((size_t)g * T + tok) * 4 + hh4];
    const float mx = fmaxf(ls[0], fmaxf(ls[1], ls[2]));
    float a[3]; float sum = 0.f;
#pragma unroll
    for (int g = 0; g < 3; ++g) { a[g] = __expf(ls[g] - mx); sum += a[g]; }
    const float inv = __builtin_amdgcn_rcpf(sum);
    float acc[8];
#pragma unroll
    for (int j = 0; j < 8; ++j) acc[j] = 0.f;
#pragma unroll
    for (int g = 0; g < 3; ++g) {
      const u32x4 v = *(const u32x4*)(QKVB + ((size_t)(g * 4 + hh4) * T + dil_row(tok, 2 * g)) * 64 + (c & 7) * 8);
      const float al = a[g] * inv;
      acc[0] += al * bflo(v.x); acc[1] += al * bfhi(v.x); acc[2] += al * bflo(v.y); acc[3] += al * bfhi(v.y);
      acc[4] += al * bflo(v.z); acc[5] += al * bfhi(v.z); acc[6] += al * bflo(v.w); acc[7] += al * bfhi(v.w);
    }
    u32x4 o;
    o.x = pack2(acc[0], acc[1]); o.y = pack2(acc[2], acc[3]); o.z = pack2(acc[4], acc[5]); o.w = pack2(acc[6], acc[7]);
    *(u32x4*)(YB + (size_t)tok * 256 + c * 8) = o;
  }
}

__global__ void __launch_bounds__(NT, 2) mk_forward(Params p) {
  cg::grid_group grid = cg::this_grid();
#define GSYNC() xcd_barrier(xb)
  __shared__ __attribute__((aligned(16))) unsigned char lds_all[131072 + 4096];
  LAS unsigned char* lds = (LAS unsigned char*)lds_all;
  u16* sm = (u16*)lds_all;
  float* smf = (float*)(lds_all + 131072);
  volatile LAS unsigned* xst = (volatile LAS unsigned*)(lds_all + 131072 + 4096 - 32);
  if (threadIdx.x == 0) { xst[0] = 0u; xst[1] = 0u; }
  __syncthreads();
  const XcdBarrier xb = xcd_barrier_post((unsigned*)(p.ws + OFF_BAR), xst);
#pragma unroll 1
  for (int l = 0; l < 2; ++l) {
    const int G = gdim_l();
    char* ws = ptr_l(p.ws);
    const float* xin = (l == 0) ? p.x : p.out;
    conv_layer(p, l, sm);
    float* PA = (float*)(ws + OFF_PA); float* PB = (float*)(ws + OFF_PB);
    if (l == 0) { rope_tables(p); x16_rows(p.x, (u16*)(ws + OFF_H), PA); }
    if (l == 0) grid.sync(); else GSYNC();
#if defined(GEMM_TRUE_XCC)
    const int c = bid_l();
#elif defined(GEMM_CHUNK_XCC)
    const int vb_ = bid_l(); const int c = (vb_ & 7) * 32 + (vb_ >> 3);
#else
    int c = blockIdx.x; asm volatile("" : "+s"(c));
#endif
    {
      SchedSimple S{ws + OFF_H, ws + OFF_W + W_IN * 2, 1024, 128, 16, 17, G, c};
      gemm_phase<true, true, true>(lds, S, EpiP1{ws}, PA, 1.f / 1024.f, 4);
    }
    GSYNC();
    {
      SchedSimple Sq{ws + OFF_CQ, ws + OFF_W + W_UQ * 2, 256, 128, 4, 3, G, c};
      gemm_phase<true, true, true>(lds, Sq, EpiP2q{ws}, (const float*)(ws + OFF_PQ), 1.f / 256.f, 1);
      SchedSimple Skv{ws + OFF_CKV, ws + OFF_W + W_UKV * 2, 128, 128, 2, 4, G, c};
      gemm_phase<true, true, false>(lds, Skv, EpiP2kv{ws});
    }
    GSYNC();
    phase_attn(p, l, sm, smf);
    GSYNC();
    phase_dilmerge(p);
    {
      SchedSimple S{ws + OFF_H, ws + OFF_W + W_G * 2, 1024, 128, 16, 12, G, c};
      gemm_phase<true, true, true>(lds, S, EpiGate{ws}, PA, 1.f / 1024.f, 4);
    }
    GSYNC();
    {
      SchedMerge S{ws, G, c};
      gemm_phase<true, false, false>(lds, S, EpiMerge{ws, (u16*)p.out});
    }
    GSYNC();
    {
      SchedSimple S{(const char*)p.out, ws + OFF_W + W_O * 2, 1024, 128, 16, 4, G, c};
      gemm_phase<false, true, false>(lds, S, EpiResid{(l == 0) ? p.x : nullptr, (l == 0) ? nullptr : (const u16*)(ws + OFF_H), nullptr, (u16*)(ws + OFF_KVA), PB});
    }
    GSYNC();
    {
      SchedSimple S{ws + OFF_KVA, ws + OFF_W + W_13 * 2, 1024, 128, 16, 22, G, c};
      gemm_phase<true, true, true>(lds, S, EpiFFN{ws}, PB, 1.f / 1024.f, 4);
#ifdef PROBE_FFN
      GSYNC(); gemm_phase<true, true, true>(lds, S, EpiFFN{ws}, PB, 1.f / 1024.f, 4);
#endif
#ifdef PROBE_FFN_NOLOAD
      GSYNC(); gemm_phase<true, true, false>(lds, S, EpiFFN_NoLoad{ws}); GSYNC(); gemm_phase<true, true, true>(lds, S, EpiFFN{ws}, PB, 1.f / 1024.f, 4);
#endif
#ifdef PROBE_FFN_NULL
      GSYNC(); gemm_phase<true, true, false>(lds, S, EpiNull{});
#endif
    }
    GSYNC();
    {
      SchedSimple S{ws + OFF_QKVB, ws + OFF_W + W_2 * 2, 2816, 128, 44, 4, G, c};
      gemm_phase<false, true, false>(lds, S, EpiResid{nullptr, (const u16*)(ws + OFF_KVA), (l == 1) ? p.out : nullptr, (l == 1) ? nullptr : (u16*)(ws + OFF_H), PA});
    }
    GSYNC();
  }
  scale_rows_f32(p.out, (const float*)(p.ws + OFF_PA), p.g_final);
}

extern "C" void kernel_launch(void* const* d_in, const int* in_sizes, int n_in, void* d_out, int out_size, void* d_ws,
                              size_t ws_size, hipStream_t stream) {
  static int grid_blocks = 0;
  if (!grid_blocks) {
    int dev = 0, cus = 0, per_cu = 0;
    (void)hipGetDevice(&dev);
    (void)hipDeviceGetAttribute(&cus, hipDeviceAttributeMultiprocessorCount, dev);
    (void)hipOccupancyMaxActiveBlocksPerMultiprocessor(&per_cu, mk_forward, NT, 0);
    if (per_cu < 1) per_cu = 1;
    grid_blocks = cus;
    if (grid_blocks > 256) grid_blocks = 256;
  }
  Params p{};
  p.x = (const float*)d_in[0]; p.w_in = (const float*)d_in[1]; p.g_mix = (const float*)d_in[2];
  p.g_q = (const float*)d_in[3]; p.g_kv = (const float*)d_in[4]; p.w_uq = (const float*)d_in[5];
  p.w_ukv = (const float*)d_in[6]; p.rpb = (const float*)d_in[7]; p.w_pa = (const float*)d_in[8];
  p.w_pb = (const float*)d_in[9]; p.w_pc = (const float*)d_in[10]; p.w_o = (const float*)d_in[11];
  p.g_ffn = (const float*)d_in[12]; p.w1 = (const float*)d_in[13]; p.w3 = (const float*)d_in[14];
  p.w2 = (const float*)d_in[15]; p.g_final = (const float*)d_in[16];
  p.out = (float*)d_out;
  p.ws = (char*)d_ws;
  (void)hipMemsetAsync((char*)d_ws + OFF_BAR, 0, XCD_BAR_WORDS * 4, stream);
  void* args[] = {&p};
  hipError_t e = hipLaunchCooperativeKernel((void*)mk_forward, dim3(grid_blocks), dim3(NT), args, 0, stream);
  if (e != hipSuccess) fprintf(stderr, "cooperative launch failed: %s (grid %d)\n", hipGetErrorString(e), grid_blocks);
}
```

```cpp
#include <hip/hip_runtime.h>
#include <hip/hip_cooperative_groups.h>
#include <cstdio>
namespace cg = cooperative_groups;

typedef unsigned short u16;
typedef __attribute__((ext_vector_type(8))) short bf16x8;
typedef __attribute__((ext_vector_type(4))) short s16x4;
typedef __attribute__((ext_vector_type(16))) float f32x16;
typedef __attribute__((ext_vector_type(4))) float f32x4;
typedef __attribute__((ext_vector_type(2))) __bf16 bf16v2;
typedef __attribute__((ext_vector_type(4))) unsigned u32x4;
typedef __attribute__((ext_vector_type(2))) unsigned u32x2;
#define DI __device__ __forceinline__
#define LAS __attribute__((address_space(3)))
#define MFMA(a, b, c) __builtin_amdgcn_mfma_f32_32x32x16_bf16((a), (b), (c), 0, 0, 0)

constexpr int NT = 512;
constexpr int T = 32768;
constexpr int SEQ = 8192;
constexpr float LOG2E = 1.4426950408889634f;
constexpr float LN2 = 0.6931471805599453f;
constexpr float EPS = 1e-6f;

constexpr size_t MiB = 1024ull * 1024ull;
constexpr size_t OFF_W = 0;
constexpr size_t OFF_CS64 = 40 * MiB;
constexpr size_t OFF_CS32 = 42 * MiB;
constexpr size_t OFF_RSQ = 43 * MiB;
constexpr size_t OFF_BAR = 43 * MiB + 512 * 1024;
constexpr size_t OFF_H = 44 * MiB;
constexpr size_t OFF_CQ = 108 * MiB;
constexpr size_t OFF_CKV = 124 * MiB;
constexpr size_t OFF_KROPE = 132 * MiB;
constexpr size_t OFF_QA = 134 * MiB;
constexpr size_t OFF_KVA = 182 * MiB;
constexpr size_t OFF_QKVB = 246 * MiB;
constexpr size_t OFF_QKVC = 390 * MiB;
constexpr size_t OFF_PQ = 486 * MiB;
constexpr size_t OFF_PKV = 486 * MiB + 512 * 1024;
constexpr size_t OFF_PA = 487 * MiB;
constexpr size_t OFF_PB = 489 * MiB;
constexpr size_t W_IN = 0;
constexpr size_t W_G = W_IN + 4352ull * 1024;
constexpr size_t W_UQ = W_G + 3072ull * 1024;
constexpr size_t W_UKV = W_UQ + 768ull * 256;
constexpr size_t W_PA = W_UKV + 1024ull * 128;
constexpr size_t W_PB = W_PA + 1024ull * 512;
constexpr size_t W_PC = W_PB + 1024ull * 256;
constexpr size_t W_O = W_PC + 1024ull * 512;
constexpr size_t W_13 = W_O + 1024ull * 1024;
constexpr size_t W_2 = W_13 + 5632ull * 1024;

struct Params {
  const float *x, *w_in, *g_mix, *g_q, *g_kv, *w_uq, *w_ukv, *rpb, *w_pa, *w_pb, *w_pc, *w_o, *g_ffn, *w1, *w3, *w2, *g_final;
  float* out;
  char* ws;
};

DI unsigned pack2(float a, float b) {
  bf16v2 v; v[0] = (__bf16)a; v[1] = (__bf16)b;
  return __builtin_bit_cast(unsigned, v);
}
DI u16 f2bf(float a) { return __builtin_bit_cast(u16, (__bf16)a); }
DI float bflo(unsigned u) { return __uint_as_float(u << 16); }
DI float bfhi(unsigned u) { return __uint_as_float(u & 0xffff0000u); }
DI int tid_l() { int t = threadIdx.x; asm volatile("" : "+v"(t)); return t; }
DI int gdim_l() { int g = gridDim.x; asm volatile("" : "+s"(g)); return g; }
DI float shx(float v, int m, int lane) { return __int_as_float(__builtin_amdgcn_ds_bpermute((lane ^ m) << 2, __float_as_int(v))); }
DI float xhalf_max(float v) {
  const auto r = __builtin_amdgcn_permlane32_swap(__float_as_uint(v), __float_as_uint(v), false, false);
  return fmaxf(__uint_as_float(r[0]), __uint_as_float(r[1]));
}
DI float xhalf_sum(float v) {
  const auto r = __builtin_amdgcn_permlane32_swap(__float_as_uint(v), __float_as_uint(v), false, false);
  return __uint_as_float(r[0]) + __uint_as_float(r[1]);
}
DI float xrows_sum(float v) {
  const auto a = __builtin_amdgcn_permlane16_swap(__float_as_uint(v), __float_as_uint(v), false, false);
  const float s = __uint_as_float(a[0]) + __uint_as_float(a[1]);
  const auto b = __builtin_amdgcn_permlane32_swap(__float_as_uint(s), __float_as_uint(s), false, false);
  return __uint_as_float(b[0]) + __uint_as_float(b[1]);
}
DI float wave_sum(float v, int lane) {
#pragma unroll
  for (int m = 32; m >= 1; m >>= 1) v += shx(v, m, lane);
  return v;
}
DI int bid_l() { int b = blockIdx.x; asm volatile("" : "+s"(b)); return b; }
DI char* ptr_l(char* q) { size_t z = 0; asm volatile("" : "+s"(z)); return q + z; }
DI int crow(int reg, int hh) { return (reg & 3) + 8 * (reg >> 2) + 4 * hh; }
DI float sigmoidf_(float x) { return __builtin_amdgcn_rcpf(1.f + __builtin_amdgcn_exp2f(-x * LOG2E)); }
DI int p64(int d) { return 8 * ((d & 31) >> 2) + (d & 3) + 4 * (d >> 5); }
DI int p32(int d) { return 8 * ((d & 15) >> 2) + (d & 3) + 4 * (d >> 4); }


#define XB_TMO      128
#define XB_XCNT(j)  (256  + 64 * (j))
#define XB_XSUB(j)  (1280 + 64 * (j))
#define XB_XGEN(j)  (2304 + 64 * (j))
#define XB_TOP      3328
#define XB_TOPGEN   3392
#define XB_CENSUS(j) (3456 + 64 * (j))
#define XCD_BAR_WORDS 4096
#define XB_SPIN_CAP (1u << 18)
DI unsigned xb_ld(unsigned* p) { return __hip_atomic_load(p, __ATOMIC_RELAXED, __HIP_MEMORY_SCOPE_AGENT); }
DI unsigned xb_add(unsigned* p, unsigned v) { return __hip_atomic_fetch_add(p, v, __ATOMIC_RELAXED, __HIP_MEMORY_SCOPE_AGENT); }
DI unsigned xb_xcc_id() { return (unsigned)__builtin_amdgcn_s_getreg((3 << 11) | 20) & 0xFu; }
#define XB_SPIN(cond, bar) do { unsigned _sp = 0; while (cond) { __builtin_amdgcn_s_sleep(1); \
    if ((++_sp & 255u) == 0u) { if (xb_ld(&(bar)[XB_TMO])) break; if (_sp > XB_SPIN_CAP) { atomicAdd(&(bar)[XB_TMO], 1u); break; } } } } while (0)
struct XcdBarrier { unsigned* bar; unsigned x; volatile LAS unsigned* st; };
DI XcdBarrier xcd_barrier_post(unsigned* bar, volatile LAS unsigned* st) {
  XcdBarrier b; b.bar = bar; b.x = xb_xcc_id(); b.st = st;
  if (threadIdx.x == 0) (void)xb_add(&bar[XB_XCNT(b.x)], 1u);
  return b;
}
DI void xcd_barrier_complete(unsigned* bar, unsigned x, unsigned& nloc, unsigned& nx) {
  const unsigned G = gridDim.x * gridDim.y * gridDim.z;
  unsigned sum, cnt, mine, sp = 0u;
  for (;;) {
    sum = 0u; cnt = 0u; mine = 0u;
#pragma unroll
    for (unsigned j = 0; j < 16; ++j) { const unsigned c = xb_ld(&bar[XB_XCNT(j)]); sum += c; cnt += (c > 0u) ? 1u : 0u; mine = (j == x) ? c : mine; }
    if (sum == G) break;
    __builtin_amdgcn_s_sleep(1);
    if ((++sp & 255u) == 0u) { if (xb_ld(&bar[XB_TMO])) break; if (sp > XB_SPIN_CAP) { atomicAdd(&bar[XB_TMO], 1u); break; } }
  }
  nloc = mine > 0u ? mine : 1u; nx = cnt > 0u ? cnt : 1u;
}
DI void xcd_barrier(const XcdBarrier& b) {
  asm volatile("s_waitcnt vmcnt(0)" ::: "memory");
  __syncthreads();
  if (threadIdx.x == 0) {
    unsigned* bar = b.bar;
    __builtin_amdgcn_s_waitcnt(0);
    unsigned nloc = b.st[0], nx = b.st[1];
    if (nloc == 0u) { xcd_barrier_complete(bar, b.x, nloc, nx); b.st[0] = nloc; b.st[1] = nx; }
    const unsigned old = xb_add(&bar[XB_XSUB(b.x)], 1u);
    const unsigned gen = old / nloc;
    if (old + 1u == (gen + 1u) * nloc) {
      __builtin_amdgcn_fence(__ATOMIC_RELEASE, "agent");
      asm volatile("s_waitcnt vmcnt(0)" ::: "memory");
      const unsigned og = xb_add(&bar[XB_TOP], 1u);
      const unsigned tg = og / nx;
      if (og + 1u == (tg + 1u) * nx) xb_add(&bar[XB_TOPGEN], 1u);
      else XB_SPIN(xb_ld(&bar[XB_TOPGEN]) == tg, bar);
      __builtin_amdgcn_fence(__ATOMIC_ACQUIRE, "agent");
      xb_add(&bar[XB_XGEN(b.x)], 1u);
      asm volatile("s_waitcnt vmcnt(0)" ::: "memory");
    } else {
      XB_SPIN(xb_ld(&bar[XB_XGEN(b.x)]) == gen, bar);
      __builtin_amdgcn_fence(__ATOMIC_ACQUIRE, "agent");
      asm volatile("s_waitcnt vmcnt(0)" ::: "memory");
    }
  }
  __syncthreads();
}

DI int conv_dst_row(int mode, int r0, int c) {
  if (mode == 1) return r0 + (c & ~63) + p64(c & 63);
  if (mode == 2) return ((c >> 5) % 3 == 2) ? (r0 + (c & ~31) + p32(c & 31)) : (r0 + c);
  if (mode == 3) return r0 + p32(c & 31);
  if (mode == 4) return r0 + (c >> 7) * 256 + (c & 127);
  return r0 + c;
}
DI void conv_job(const float* __restrict__ src, int K, int ld, int c0, int ncols, u16* __restrict__ dst, int r0, int mode,
                 const float* __restrict__ g, u16* sm, int& base) {
  const int nct = (ncols + 63) >> 6, nkt = K >> 6, ntile = nct * nkt;
  const int t = tid_l();
  const int G = gdim_l();
  int first = (bid_l() - (base % G) + G) % G;
  base += ntile;
  for (int tile = first; tile < ntile; tile += G) {
    const int ct = tile % nct, kt = tile / nct;
    const int c = t & 63, kk = t >> 6;
    const bool cv = (ct * 64 + c) < ncols;
    __syncthreads();
#pragma unroll 4
    for (int i = 0; i < 8; ++i) {
      const int k = kk + 8 * i;
      float v = cv ? src[(size_t)(kt * 64 + k) * ld + c0 + ct * 64 + c] : 0.f;
      if (g) v *= g[kt * 64 + k];
      sm[c * 66 + k] = f2bf(v);
    }
    __syncthreads();
    const int row = t >> 3, part = t & 7;
    if (ct * 64 + row < ncols) {
      const unsigned* s32 = (const unsigned*)(sm + row * 66 + part * 8);
      u32x4 a;
      a.x = s32[0]; a.y = s32[1]; a.z = s32[2]; a.w = s32[3];
      u16* d = dst + (size_t)conv_dst_row(mode, r0, ct * 64 + row) * K + kt * 64 + part * 8;
      *(u32x4*)d = a;
    }
  }
}

DI void conv_layer(const Params& p, int l, u16* sm) {
  u16* W = (u16*)(ptr_l(p.ws) + OFF_W);
  int base = 0;
  const float* win = p.w_in + (size_t)l * 1024 * 7328;
  const float* gm = p.g_mix + l * 1024;
  const float* gf = p.g_ffn + l * 1024;
  conv_job(win, 1024, 7328, 416, 1536, W + W_IN, 512, 1, gm, sm, base);
  conv_job(win, 1024, 7328, 416 + 1536, 768 + 1536, W + W_IN, 2048, 0, gm, sm, base);
  conv_job(win, 1024, 7328, 4256, 3072, W + W_G, 0, 0, gm, sm, base);
  conv_job(p.w1 + (size_t)l * 1024 * 2816, 1024, 2816, 0, 2816, W + W_13, 0, 4, gf, sm, base);
  conv_job(p.w3 + (size_t)l * 1024 * 2816, 1024, 2816, 0, 2816, W + W_13, 128, 4, gf, sm, base);
  conv_job(p.w2 + (size_t)l * 2816 * 1024, 2816, 1024, 0, 1024, W + W_2, 0, 0, nullptr, sm, base);
  conv_job(p.w_o + (size_t)l * 1024 * 1024, 1024, 1024, 0, 1024, W + W_O, 0, 0, nullptr, sm, base);
  conv_job(win, 1024, 7328, 0, 384, W + W_IN, 0, 0, gm, sm, base);
  conv_job(win, 1024, 7328, 384, 32, W + W_IN, 384, 3, gm, sm, base);
  conv_job(p.w_pa + (size_t)l * 512 * 1024, 512, 1024, 0, 1024, W + W_PA, 0, 0, nullptr, sm, base);
  conv_job(p.w_pc + (size_t)l * 512 * 1024, 512, 1024, 0, 1024, W + W_PC, 0, 0, nullptr, sm, base);
  conv_job(p.w_pb + (size_t)l * 256 * 1024, 256, 1024, 0, 1024, W + W_PB, 0, 0, nullptr, sm, base);
  conv_job(p.w_uq + (size_t)l * 256 * 768, 256, 768, 0, 768, W + W_UQ, 0, 2, p.g_q + l * 256, sm, base);
  conv_job(p.w_ukv + (size_t)l * 128 * 1024, 128, 1024, 0, 1024, W + W_UKV, 0, 0, p.g_kv + l * 128, sm, base);
}

DI void rope_tables(const Params& p) {
  char* ws = ptr_l(p.ws);
  float2* cs64 = (float2*)(ws + OFF_CS64);
  float2* cs32 = (float2*)(ws + OFF_CS32);
  const int stride = gdim_l() * NT;
  for (int i = bid_l() * NT + tid_l(); i < SEQ * 48; i += stride) {
    int pos; float ex; float2* dst;
    if (i < SEQ * 32) { pos = i >> 5; ex = (float)(i & 31) * (1.f / 32.f); dst = cs64 + i; }
    else { const int j = i - SEQ * 32; pos = j >> 4; ex = (float)(j & 15) * (1.f / 16.f); dst = cs32 + j; }
    const float inv = __builtin_amdgcn_exp2f(-ex * 13.287712379549449f);
    const float ang = (float)pos * inv;
    const double tt = (double)ang * 0.15915494309189535;
    const float fr = (float)(tt - floor(tt));
    *dst = make_float2(__builtin_amdgcn_cosf(fr), __builtin_amdgcn_sinf(fr));
  }
}
DI void zero_f32(float* r, int n) {
  const int stride = gdim_l() * NT;
  for (int i = bid_l() * NT + tid_l(); i < n; i += stride) r[i] = 0.f;
}

DI void x16_rows(const float* __restrict__ x, u16* __restrict__ out, float* __restrict__ rowsq) {
  const int t_ = tid_l(); const int lane = t_ & 63, w = t_ >> 6;
  for (int row = bid_l() * 8 + w; row < T; row += gdim_l() * 8) {
    const float4* xr = (const float4*)(x + (size_t)row * 1024);
    float4 v[4]; float ss = 0.f;
#pragma unroll
    for (int i = 0; i < 4; ++i) { v[i] = xr[lane + 64 * i]; ss += v[i].x * v[i].x + v[i].y * v[i].y + v[i].z * v[i].z + v[i].w * v[i].w; }
    ss = wave_sum(ss, lane);
    if (lane < 16) rowsq[(size_t)row * 16 + lane] = (lane == 0) ? ss : 0.f;
#pragma unroll
    for (int i = 0; i < 4; ++i) {
      u32x2 o; o.x = pack2(v[i].x, v[i].y); o.y = pack2(v[i].z, v[i].w);
      *(u32x2*)(out + (size_t)row * 1024 + 4 * (lane + 64 * i)) = o;
    }
  }
}
DI void scale_rows_f32(float* __restrict__ x, const float* __restrict__ rowsq, const float* __restrict__ g) {
  const int t_ = tid_l(); const int lane = t_ & 63, w = t_ >> 6;
  for (int row = bid_l() * 8 + w; row < T; row += gdim_l() * 8) {
    float4* xr = (float4*)(x + (size_t)row * 1024);
    float sq_ = 0.f;
    { const f32x4* pr_ = (const f32x4*)rowsq + (size_t)row * 4;
#pragma unroll
      for (int j = 0; j < 4; ++j) { const f32x4 q_ = pr_[j]; sq_ += (q_[0] + q_[1]) + (q_[2] + q_[3]); } }
    const float rs = rsqrtf(sq_ * (1.f / 1024.f) + EPS);
#pragma unroll
    for (int i = 0; i < 4; ++i) {
      const float4 v = xr[lane + 64 * i];
      const float4 gg = ((const float4*)g)[lane + 64 * i];
      xr[lane + 64 * i] = make_float4(v.x * rs * gg.x, v.y * rs * gg.y, v.z * rs * gg.z, v.w * rs * gg.w);
    }
  }
}
DI void scale_rows_from16(const u16* __restrict__ x16, float* __restrict__ out, const float* __restrict__ rowsq, const float* __restrict__ g) {
  const int t_ = tid_l(); const int lane = t_ & 63, w = t_ >> 6;
  for (int row = bid_l() * 8 + w; row < T; row += gdim_l() * 8) {
    const u32x4* xr = (const u32x4*)(x16 + (size_t)row * 1024);
    float4* orow = (float4*)(out + (size_t)row * 1024);
    const float rs = rsqrtf(rowsq[row] * (1.f / 1024.f) + EPS);
#pragma unroll
    for (int i = 0; i < 2; ++i) {
      const u32x4 v = xr[lane + 64 * i];
      const float4 g0 = ((const float4*)g)[2 * (lane + 64 * i)], g1 = ((const float4*)g)[2 * (lane + 64 * i) + 1];
      orow[2 * (lane + 64 * i)] = make_float4(bflo(v.x) * rs * g0.x, bfhi(v.x) * rs * g0.y, bflo(v.y) * rs * g0.z, bfhi(v.y) * rs * g0.w);
      orow[2 * (lane + 64 * i) + 1] = make_float4(bflo(v.z) * rs * g1.x, bfhi(v.z) * rs * g1.y, bflo(v.w) * rs * g1.z, bfhi(v.w) * rs * g1.w);
    }
  }
}
DI void norm_rows_bf16(const float* __restrict__ x, const float* __restrict__ g, u16* __restrict__ out) {
  const int t_ = tid_l(); const int lane = t_ & 63, w = t_ >> 6;
  for (int row = bid_l() * 8 + w; row < T; row += gdim_l() * 8) {
    const float4* xr = (const float4*)(x + (size_t)row * 1024);
    float4 v[4]; float ss = 0.f;
#pragma unroll
    for (int i = 0; i < 4; ++i) { v[i] = xr[lane + 64 * i]; ss += v[i].x * v[i].x + v[i].y * v[i].y + v[i].z * v[i].z + v[i].w * v[i].w; }
    ss = wave_sum(ss, lane);
    const float rs = rsqrtf(ss * (1.f / 1024.f) + EPS);
#pragma unroll
    for (int i = 0; i < 4; ++i) {
      const float4 gg = ((const float4*)g)[lane + 64 * i];
      u32x2 o; o.x = pack2(v[i].x * rs * gg.x, v[i].y * rs * gg.y); o.y = pack2(v[i].z * rs * gg.z, v[i].w * rs * gg.w);
      *(u32x2*)(out + (size_t)row * 1024 + 4 * (lane + 64 * i)) = o;
    }
  }
}
DI void norm_rows_f32(float* __restrict__ x, const float* __restrict__ g) {
  const int t_ = tid_l(); const int lane = t_ & 63, w = t_ >> 6;
  for (int row = bid_l() * 8 + w; row < T; row += gdim_l() * 8) {
    float4* xr = (float4*)(x + (size_t)row * 1024);
    float4 v[4]; float ss = 0.f;
#pragma unroll
    for (int i = 0; i < 4; ++i) { v[i] = xr[lane + 64 * i]; ss += v[i].x * v[i].x + v[i].y * v[i].y + v[i].z * v[i].z + v[i].w * v[i].w; }
    ss = wave_sum(ss, lane);
    const float rs = rsqrtf(ss * (1.f / 1024.f) + EPS);
#pragma unroll
    for (int i = 0; i < 4; ++i) {
      const float4 gg = ((const float4*)g)[lane + 64 * i];
      xr[lane + 64 * i] = make_float4(v[i].x * rs * gg.x, v[i].y * rs * gg.y, v[i].z * rs * gg.z, v[i].w * rs * gg.w);
    }
  }
}

constexpr int HTB = 128 * 64 * 2;
DI int lds_byte(int r, int c) { const int st = (r >> 4) * 2 + (c >> 5), rr = r & 15, cc = c & 31, ob = rr * 64 + cc * 2; return st * 1024 + (ob ^ (((ob >> 9) & 1) << 5)); }
DI void stage_rc(int b, int& R, int& C) { const int st = b / 1024, sb = b % 1024, swz = sb ^ (((sb >> 9) & 1) << 5); R = (st >> 1) * 16 + swz / 64; C = (st & 1) * 32 + (swz % 64) / 2; }
DI int perm32(int rho) { const int n = rho >> 4, i = rho & 15; return 8 * (i >> 2) + 4 * n + (i & 3); }

struct GUnit {
  const char* A;
  const char* B;
  int lda;
  int akb;
  int nt;
  int pm, pn, tag;
};

DI void static_tile(int L, int nM, int nN, int& pm, int& pn) {
#ifdef GEMM_ROWMAJ
  pm = L / nN; pn = L - pm * nN; return;
#endif
  const int nwg = nM * nN;
  int wgid = L;
  { const int q = nwg / 8, r = nwg % 8, xcd = wgid % 8, off = wgid / 8; wgid = (xcd < r ? xcd * (q + 1) : r * (q + 1) + (xcd - r) * q) + off; }
#ifndef WGM_
#define WGM_ 8
#endif
  const int nig = WGM_ * nN, gid = wgid / nig, fm = gid * WGM_, gsz = (nM - fm) < WGM_ ? (nM - fm) : WGM_;
  pm = fm + ((wgid % nig) % gsz); pn = (wgid % nig) / gsz;
}

template <bool PERM, bool UNI, bool RS, class Sched, class Epi>
DI void gemm_phase(LAS unsigned char* lds, const Sched& S, const Epi& E, const float* rsq = nullptr, float inv_n = 0.f, int np4 = 1) {
  const int tid = tid_l();
  const int wid = __builtin_amdgcn_readfirstlane(tid >> 6), lane = tid & 63, wr = wid >> 2, wc = wid & 3, fr = lane & 15, fq = lane >> 4;
  int R0, C0, R1, C1;
  stage_rc(tid * 16, R0, C0); stage_rc(tid * 16 + 8192, R1, C1);
  const int Rb0 = PERM ? ((R0 & ~31) + perm32(R0 & 31)) : R0, Rb1 = PERM ? ((R1 & ~31) + perm32(R1 & 31)) : R1;
  const unsigned ldsw = (unsigned)wid * 1024u;
  const int aoff = lds_byte(wr * 64 + fr, fq * 8), boff = lds_byte(wc * 32 + fr, fq * 8);
#define G_SA(b, h) (((b) * 2 + (h)) * HTB)
#define G_SB(b, h) ((4 + (b) * 2 + (h)) * HTB)
#define G_STAGE(bufoff, gbase, v0, v1) do { \
    __builtin_amdgcn_global_load_lds((const unsigned*)((const char*)(gbase) + (v0)), (LAS unsigned*)(lds + (bufoff) + ldsw), 16, 0, 0); \
    __builtin_amdgcn_global_load_lds((const unsigned*)((const char*)(gbase) + (v1)), (LAS unsigned*)(lds + (bufoff) + ldsw + 8192), 16, 0, 0); } while (0)
#define G_LDA(dst, b, h) do { _Pragma("unroll") for (int m = 0; m < 4; ++m) _Pragma("unroll") for (int k = 0; k < 2; ++k) dst[m][k] = *(const LAS bf16x8*)(lds + G_SA(b, h) + aoff + m * 2048 + k * 1024); } while (0)
#define G_LDB(dst, b, h) do { _Pragma("unroll") for (int n = 0; n < 2; ++n) _Pragma("unroll") for (int k = 0; k < 2; ++k) dst[n][k] = *(const LAS bf16x8*)(lds + G_SB(b, h) + boff + n * 2048 + k * 1024); } while (0)
#define G_MMA(ai, bj, At, Bt) do { __builtin_amdgcn_s_setprio(1); _Pragma("unroll") for (int m = 0; m < 4; ++m) _Pragma("unroll") for (int n = 0; n < 2; ++n) _Pragma("unroll") for (int k = 0; k < 2; ++k) \
    acc[ai][bj][m][n] = __builtin_amdgcn_mfma_f32_16x16x32_bf16(Bt[n][k], At[m][k], acc[ai][bj][m][n], 0, 0, 0); __builtin_amdgcn_s_setprio(0); } while (0)
#define G_WAIT_V(n) asm volatile("s_waitcnt vmcnt(" #n ")" ::: "memory")
#define G_WAIT_L(n) asm volatile("s_waitcnt lgkmcnt(" #n ")" ::: "memory")
#define G_BAR __builtin_amdgcn_s_barrier()
#define G_SCHED __builtin_amdgcn_sched_barrier(0)
#define G_MKOFF(u, a0, a1, b0, b1) do { a0 = (unsigned)(R0 * (u).lda + C0) * 2u; a1 = (unsigned)(R1 * (u).lda + C1) * 2u; \
    const int K_ = (u).nt * 64; b0 = (unsigned)(Rb0 * K_ + C0) * 2u; b1 = (unsigned)(Rb1 * K_ + C1) * 2u; } while (0)
  GUnit cur, nxt;
  int ui = 0;
  if (!S.next(0, cur)) return;
  f32x4 acc[2][2][4][2];
#pragma unroll
  for (int a = 0; a < 2; ++a)
#pragma unroll
    for (int b = 0; b < 2; ++b)
#pragma unroll
      for (int m = 0; m < 4; ++m)
#pragma unroll
        for (int n = 0; n < 2; ++n) acc[a][b][m][n] = (f32x4){0.f, 0.f, 0.f, 0.f};
  bf16x8 At[4][2], B0[2][2], B1[2][2];
  unsigned vA0, vA1, vB0, vB1;
  G_MKOFF(cur, vA0, vA1, vB0, vB1);
  LAS float* rstab = (LAS float*)(lds + 131072);
  if (RS && tid < 256) {
    const f32x4* pr_ = (const f32x4*)rsq + (size_t)(cur.pm * 256 + tid) * np4; float s_ = 0.f;
    for (int j = 0; j < np4; ++j) { const f32x4 q_ = pr_[j]; s_ += (q_[0] + q_[1]) + (q_[2] + q_[3]); }
    rstab[tid] = rsqrtf(s_ * inv_n + EPS);
  }
  const char* cA = cur.A; const char* cB = cur.B;
  size_t hA = (size_t)128 * cur.lda * 2, hB = (size_t)128 * cur.nt * 128, kA = (size_t)cur.akb;
  G_STAGE(G_SB(0, 0), cB, vB0, vB1); G_STAGE(G_SA(0, 0), cA, vA0, vA1); G_STAGE(G_SB(0, 1), cB + hB, vB0, vB1); G_STAGE(G_SA(0, 1), cA + hA, vA0, vA1);
  if (wr == 1) G_BAR;
  G_WAIT_V(4); G_BAR;
  G_STAGE(G_SB(1, 0), cB + 128, vB0, vB1); G_STAGE(G_SA(1, 0), cA + kA, vA0, vA1); G_STAGE(G_SB(1, 1), cB + hB + 128, vB0, vB1);
  G_WAIT_V(6); G_BAR;
  for (;;) {
    const bool has_next = S.next(ui + 1, nxt);
    unsigned nA0 = vA0, nA1 = vA1, nB0 = vB0, nB1 = vB1;
    const char* nA = cA; const char* nB = cB;
    size_t hAn = hA, hBn = hB, kAn = kA;
    if (has_next) { nA = nxt.A; nB = nxt.B; if (!UNI) { G_MKOFF(nxt, nA0, nA1, nB0, nB1); hAn = (size_t)128 * nxt.lda * 2; hBn = (size_t)128 * nxt.nt * 128; kAn = (size_t)nxt.akb; } }
    const int nt = cur.nt;
    for (int t = 0; t < nt; t += 2) {
      const bool last = (t == nt - 2);
      const char* a1 = cA + (size_t)(t + 1) * kA;
      const char* a2 = last ? nA : cA + (size_t)(t + 2) * kA;
      const char* b2 = last ? nB : cB + (size_t)(t + 2) * 128;
      const char* a3 = a2 + ((!UNI && last) ? kAn : kA);
      const char* b3 = b2 + 128;
      const unsigned xA0 = (!UNI && last) ? nA0 : vA0, xA1 = (!UNI && last) ? nA1 : vA1, xB0 = (!UNI && last) ? nB0 : vB0, xB1 = (!UNI && last) ? nB1 : vB1;
      const size_t xhA = (!UNI && last) ? hAn : hA, xhB = (!UNI && last) ? hBn : hB;
      G_LDB(B0, 0, 0); G_SCHED; G_LDA(At, 0, 0); G_STAGE(G_SA(1, 1), a1 + hA, vA0, vA1);
      G_WAIT_L(8); G_BAR; G_WAIT_L(0); G_MMA(0, 0, At, B0); G_BAR; G_SCHED;
      G_LDB(B1, 0, 1); G_STAGE(G_SB(0, 0), b2, xB0, xB1);
      G_BAR; G_WAIT_L(0); G_MMA(0, 1, At, B1); G_BAR;
      G_LDA(At, 0, 1); G_STAGE(G_SA(0, 0), a2, xA0, xA1);
      G_BAR; G_WAIT_L(0); G_MMA(1, 0, At, B0); G_BAR; G_SCHED;
      G_STAGE(G_SB(0, 1), b2 + xhB, xB0, xB1);
      G_WAIT_V(6); G_BAR; G_MMA(1, 1, At, B1); G_BAR;
      G_LDB(B0, 1, 0); G_SCHED; G_LDA(At, 1, 0); G_STAGE(G_SA(0, 1), a2 + xhA, xA0, xA1);
      G_WAIT_L(8); G_BAR; G_WAIT_L(0); G_MMA(0, 0, At, B0); G_BAR; G_SCHED;
      G_LDB(B1, 1, 1); G_STAGE(G_SB(1, 0), b3, xB0, xB1);
      G_BAR; G_WAIT_L(0); G_MMA(0, 1, At, B1); G_BAR;
      G_LDA(At, 1, 1); G_STAGE(G_SA(1, 0), a3, xA0, xA1);
      G_BAR; G_WAIT_L(0); G_MMA(1, 0, At, B0); G_BAR; G_SCHED;
      G_STAGE(G_SB(1, 1), b3 + xhB, xB0, xB1);
      G_WAIT_V(6); G_BAR; G_MMA(1, 1, At, B1); G_BAR;
    }
    float rnext_ = 0.f;
    if (RS && has_next && tid < 256) {
      const f32x4* pr_ = (const f32x4*)rsq + (size_t)(nxt.pm * 256 + tid) * np4;
      for (int j = 0; j < np4; ++j) { const f32x4 q_ = pr_[j]; rnext_ += (q_[0] + q_[1]) + (q_[2] + q_[3]); }
    }
    E(acc, cur, wr, wc, fr, fq, rstab + (ui & 1) * 256);
    if (RS && has_next && tid < 256) rstab[((ui + 1) & 1) * 256 + tid] = rsqrtf(rnext_ * inv_n + EPS);
    if (!has_next) break;
    if (!(Epi::CARRY && cur.tag < 2)) {
#pragma unroll
      for (int a = 0; a < 2; ++a)
#pragma unroll
        for (int b = 0; b < 2; ++b)
#pragma unroll
          for (int m = 0; m < 4; ++m)
#pragma unroll
            for (int n = 0; n < 2; ++n) acc[a][b][m][n] = (f32x4){0.f, 0.f, 0.f, 0.f};
    }
    cur = nxt; cA = nA; cB = nB; vA0 = nA0; vA1 = nA1; vB0 = nB0; vB1 = nB1; hA = hAn; hB = hBn; kA = kAn; ++ui;
  }
  G_WAIT_V(0);
  if (wr == 0) G_BAR;
  G_BAR;
#undef G_SA
#undef G_SB
#undef G_STAGE
#undef G_LDA
#undef G_LDB
#undef G_MMA
#undef G_WAIT_V
#undef G_WAIT_L
#undef G_BAR
#undef G_SCHED
#undef G_MKOFF
}

struct SchedSimple {
  const char* A; const char* B; int lda, akb, nt, nN, G, c;
  DI bool next(int i, GUnit& u) const {
    const int L = i * G + c;
    if (L >= 128 * nN) return false;
    static_tile(L, 128, nN, u.pm, u.pn);
    u.A = A + (size_t)u.pm * 256 * lda * 2; u.B = B + (size_t)u.pn * 256 * nt * 128;
    u.lda = lda; u.akb = akb; u.nt = nt; u.tag = 0;
    return true;
  }
};

DI u32x4 pack8(const f32x4 a, const f32x4 b) {
  u32x4 w; w.x = pack2(a[0], a[1]); w.y = pack2(a[2], a[3]); w.z = pack2(b[0], b[1]); w.w = pack2(b[2], b[3]); return w;
}
DI float sumsq8(const f32x4 a, const f32x4 b) {
  return a[0] * a[0] + a[1] * a[1] + a[2] * a[2] + a[3] * a[3] + b[0] * b[0] + b[1] * b[1] + b[2] * b[2] + b[3] * b[3];
}
DI void rope4(const f32x4 x1, const f32x4 x2, const f32x4 c01, const f32x4 c23, float sc, u32x2& o1, u32x2& o2) {
  const float y10 = (x1[0] * c01[0] - x2[0] * c01[1]) * sc, y20 = (x2[0] * c01[0] + x1[0] * c01[1]) * sc;
  const float y11 = (x1[1] * c01[2] - x2[1] * c01[3]) * sc, y21 = (x2[1] * c01[2] + x1[1] * c01[3]) * sc;
  const float y12 = (x1[2] * c23[0] - x2[2] * c23[1]) * sc, y22 = (x2[2] * c23[0] + x1[2] * c23[1]) * sc;
  const float y13 = (x1[3] * c23[2] - x2[3] * c23[3]) * sc, y23 = (x2[3] * c23[2] + x1[3] * c23[3]) * sc;
  o1.x = pack2(y10, y11); o1.y = pack2(y12, y13); o2.x = pack2(y20, y21); o2.y = pack2(y22, y23);
}
DI int dil_row(int row, int dsh) { const int s_ = row & (SEQ - 1); return (row & ~(SEQ - 1)) + ((s_ & ((1 << dsh) - 1)) << (13 - dsh)) + (s_ >> dsh); }
#define EPI_ROW(it_) (row0 + ((it_) >> 2) * 128 + ((it_) & 3) * 16)
#define EPI_LROW(it_) (wr * 64 + fr + ((it_) >> 2) * 128 + ((it_) & 3) * 16)

struct EpiP1 {
  static constexpr bool CARRY = false;
  char* ws;
  DI void operator()(f32x4 (&acc)[2][2][4][2], const GUnit& u, int wr, int wc, int fr, int fq, const LAS float* rst) const {
    asm volatile("" : "+v"(fr), "+v"(fq));
    u16* CQ = (u16*)(ws + OFF_CQ); u16* CKV = (u16*)(ws + OFF_CKV); u16* KROPE = (u16*)(ws + OFF_KROPE);
    u16* QKVB = (u16*)(ws + OFF_QKVB); u16* QKVC = (u16*)(ws + OFF_QKVC);
    float* RSQ = (float*)(ws + OFF_RSQ);
    const float2* cs64 = (const float2*)(ws + OFF_CS64);
    const float2* cs32 = (const float2*)(ws + OFF_CS32);
    const float QS = 0.125f * LOG2E;
    const int row0 = u.pm * 256 + wr * 64 + fr;
    const int pn = u.pn;
    float rsv[8];
#pragma unroll
    for (int it = 0; it < 8; ++it) rsv[it] = rst[EPI_LROW(it)];
    if (pn < 2) {
      const bool kr = (pn == 1) && (wc == 0);
      f32x4 c01 = {0.f, 0.f, 0.f, 0.f}, c23 = c01;
      if (kr) { const float2* cp = cs32 + (EPI_ROW(0) & (SEQ - 1)) * 16 + 4 * fq; c01 = *(const f32x4*)cp; c23 = *(const f32x4*)(cp + 2); }
#pragma unroll
      for (int it = 0; it < 8; ++it) {
        const int ai = it >> 2, m = it & 3;
        const int row = EPI_ROW(it);
        f32x4 n01 = c01, n23 = c23;
        if (kr && it + 1 < 8) { const float2* cp = cs32 + (EPI_ROW(it + 1) & (SEQ - 1)) * 16 + 4 * fq; n01 = *(const f32x4*)cp; n23 = *(const f32x4*)(cp + 2); }
        float ss = 0.f;
#pragma unroll
        for (int bj = 0; bj < 2; ++bj) {
          const f32x4 v0 = acc[ai][bj][m][0] * rsv[it], v1 = acc[ai][bj][m][1] * rsv[it];
          if (pn == 0) {
            *(u32x4*)(CQ + (size_t)row * 256 + bj * 128 + wc * 32 + 8 * fq) = pack8(v0, v1);
            ss += sumsq8(v0, v1);
          } else if (bj == 0) {
            *(u32x4*)(CKV + (size_t)row * 128 + wc * 32 + 8 * fq) = pack8(v0, v1);
            ss += sumsq8(v0, v1);
          } else if (wc == 0) {
            u32x2 o1, o2;
            rope4(v0, v1, c01, c23, 1.f, o1, o2);
            *(u32x2*)(KROPE + (size_t)row * 32 + 4 * fq) = o1;
            *(u32x2*)(KROPE + (size_t)row * 32 + 16 + 4 * fq) = o2;
          }
        }
        ss = xrows_sum(ss);
        if (fq == 0) ((float*)(ws + (pn == 0 ? OFF_PQ : OFF_PKV)))[(size_t)row * 4 + wc] = ss;
        c01 = n01; c23 = n23;
      }
    } else if (pn < 11) {
      const int tsel = (pn - 2) / 3;
      if (tsel < 2) {
        const int q = (wc & 1) * 4 + fq;
        const float sc = (tsel == 0) ? QS : 1.f;
        const float2* cp0 = cs64 + (EPI_ROW(0) & (SEQ - 1)) * 32 + 4 * q;
        f32x4 c01 = *(const f32x4*)cp0, c23 = *(const f32x4*)(cp0 + 2);
#pragma unroll
        for (int it = 0; it < 8; ++it) {
          const int ai = it >> 2, m = it & 3;
          const int row = EPI_ROW(it);
          f32x4 n01 = c01, n23 = c23;
          if (it + 1 < 8) { const float2* cp = cs64 + (EPI_ROW(it + 1) & (SEQ - 1)) * 32 + 4 * q; n01 = *(const f32x4*)cp; n23 = *(const f32x4*)(cp + 2); }
#pragma unroll
          for (int bj = 0; bj < 2; ++bj) {
            const int colg = (pn - 2) * 256 + bj * 128 + wc * 32;
            u32x2 o1, o2;
            rope4(acc[ai][bj][m][0], acc[ai][bj][m][1], c01, c23, sc * rsv[it], o1, o2);
            u16* d = QKVB + ((size_t)(colg >> 6) * T + dil_row(row, 2 * ((((colg >> 6) % 12)) >> 2))) * 64 + 4 * q;
            *(u32x2*)d = o1;
            *(u32x2*)(d + 32) = o2;
          }
          c01 = n01; c23 = n23;
        }
      } else {
#pragma unroll
        for (int it = 0; it < 8; ++it) {
          const int ai = it >> 2, m = it & 3;
          const int row = EPI_ROW(it);
#pragma unroll
          for (int bj = 0; bj < 2; ++bj) {
            const int colg = (pn - 2) * 256 + bj * 128 + wc * 32;
            *(u32x4*)(QKVB + ((size_t)(colg >> 6) * T + dil_row(row, 2 * ((((colg >> 6) % 12)) >> 2))) * 64 + (colg & 63) + 8 * fq) = pack8(acc[ai][bj][m][0] * rsv[it], acc[ai][bj][m][1] * rsv[it]);
          }
        }
      }
    } else {
      const float sc = (pn - 11 < 2) ? QS : 1.f;
#pragma unroll
      for (int it = 0; it < 8; ++it) {
        const int ai = it >> 2, m = it & 3;
        const int row = EPI_ROW(it);
#pragma unroll
        for (int bj = 0; bj < 2; ++bj) {
          const int cc = (pn - 11) * 256 + bj * 128 + wc * 32 + 8 * fq;
          *(u32x4*)(QKVC + ((size_t)(cc >> 6) * T + row) * 64 + (cc & 63)) = pack8(acc[ai][bj][m][0] * (sc * rsv[it]), acc[ai][bj][m][1] * (sc * rsv[it]));
        }
      }
    }
  }
};

struct EpiP2q {
  static constexpr bool CARRY = false;
  char* ws;
  DI void operator()(f32x4 (&acc)[2][2][4][2], const GUnit& u, int wr, int wc, int fr, int fq, const LAS float* rst) const {
    asm volatile("" : "+v"(fr), "+v"(fq));
    u16* QA = (u16*)(ws + OFF_QA);
    const float2* cs32 = (const float2*)(ws + OFF_CS32);
    const float QS = 0.10206207261596575f * LOG2E;
    const int row0 = u.pm * 256 + wr * 64 + fr;
    float rsv[8];
#pragma unroll
    for (int it = 0; it < 8; ++it) rsv[it] = rst[EPI_LROW(it)] * QS;
#pragma unroll
    for (int bj = 0; bj < 2; ++bj) {
      const int colg = u.pn * 256 + bj * 128 + wc * 32;
      const bool rope = (colg % 96) == 64;
      if (rope) {
        const float2* cp0 = cs32 + (EPI_ROW(0) & (SEQ - 1)) * 16 + 4 * fq;
        f32x4 c01 = *(const f32x4*)cp0, c23 = *(const f32x4*)(cp0 + 2);
#pragma unroll
        for (int it = 0; it < 8; ++it) {
          const int ai = it >> 2, m = it & 3;
          const int row = EPI_ROW(it);
          f32x4 n01 = c01, n23 = c23;
          if (it + 1 < 8) { const float2* cp = cs32 + (EPI_ROW(it + 1) & (SEQ - 1)) * 16 + 4 * fq; n01 = *(const f32x4*)cp; n23 = *(const f32x4*)(cp + 2); }
          u32x2 o1, o2;
          rope4(acc[ai][bj][m][0], acc[ai][bj][m][1], c01, c23, rsv[it], o1, o2);
          *(u32x2*)(QA + (size_t)row * 768 + colg + 4 * fq) = o1;
          *(u32x2*)(QA + (size_t)row * 768 + colg + 16 + 4 * fq) = o2;
          c01 = n01; c23 = n23;
        }
      } else {
#pragma unroll
        for (int it = 0; it < 8; ++it) {
          const int ai = it >> 2, m = it & 3;
          *(u32x4*)(QA + (size_t)EPI_ROW(it) * 768 + colg + 8 * fq) = pack8(acc[ai][bj][m][0] * rsv[it], acc[ai][bj][m][1] * rsv[it]);
        }
      }
    }
  }
};
struct EpiP2kv {
  static constexpr bool CARRY = false;
  char* ws;
  DI void operator()(f32x4 (&acc)[2][2][4][2], const GUnit& u, int wr, int wc, int fr, int fq, const LAS float* rst) const {
    asm volatile("" : "+v"(fr), "+v"(fq));
    u16* KVA = (u16*)(ws + OFF_KVA);
    const float* RSQ = (const float*)(ws + OFF_RSQ);
    const int row0 = u.pm * 256 + wr * 64 + fr;
    float rsv[8];
#pragma unroll
    for (int it = 0; it < 8; ++it) { const f32x4 q_ = ((const f32x4*)(ws + OFF_PKV))[EPI_ROW(it)]; rsv[it] = (q_[0] + q_[1]) + (q_[2] + q_[3]); }
#pragma unroll
    for (int it = 0; it < 8; ++it) {
      const int ai = it >> 2, m = it & 3;
      const int row = EPI_ROW(it);
      const float rs = rsqrtf(rsv[it] * (1.f / 128.f) + EPS);
#pragma unroll
      for (int bj = 0; bj < 2; ++bj)
        *(u32x4*)(KVA + (size_t)row * 1024 + u.pn * 256 + bj * 128 + wc * 32 + 8 * fq) = pack8(acc[ai][bj][m][0] * rs, acc[ai][bj][m][1] * rs);
    }
  }
};

DI unsigned char* gate_ptr(char* ws, int br, int row) {
  if (br == 0) return (unsigned char*)(ws + OFF_KVA) + (size_t)row * 2048;
  if (br == 1) return (unsigned char*)(ws + OFF_QKVB) + (size_t)12 * T * 128 + (size_t)row * 1024;
  return (unsigned char*)(ws + OFF_QKVC) + (size_t)8 * T * 128 + (size_t)row * 1024;
}
DI unsigned pack4_u8(const f32x4 v) {
  unsigned r = 0u;
  r = __builtin_amdgcn_cvt_pk_u8_f32(fmaxf(v[0] * 255.f, 0.51f), 0, r); r = __builtin_amdgcn_cvt_pk_u8_f32(fmaxf(v[1] * 255.f, 0.51f), 1, r);
  r = __builtin_amdgcn_cvt_pk_u8_f32(fmaxf(v[2] * 255.f, 0.51f), 2, r); r = __builtin_amdgcn_cvt_pk_u8_f32(fmaxf(v[3] * 255.f, 0.51f), 3, r);
  return r;
}
DI f32x4 unpack4_u8(unsigned r) {
  const float k = 1.f / 255.f;
  return (f32x4){(float)(r & 0xffu) * k, (float)((r >> 8) & 0xffu) * k, (float)((r >> 16) & 0xffu) * k, (float)(r >> 24) * k};
}
struct EpiGate {
  static constexpr bool CARRY = false;
  char* ws;
  DI void operator()(f32x4 (&acc)[2][2][4][2], const GUnit& u, int wr, int wc, int fr, int fq, const LAS float* rst) const {
    asm volatile("" : "+v"(fr), "+v"(fq));
    const int row0 = u.pm * 256 + wr * 64 + fr;
    const int br = u.pn >> 2;
    const float* RSQ = (const float*)(ws + OFF_RSQ);
    float rsv[8];
#pragma unroll
    for (int it = 0; it < 8; ++it) rsv[it] = rst[EPI_LROW(it)];
#pragma unroll
    for (int it = 0; it < 8; ++it) {
      const int ai = it >> 2, m = it & 3;
      const int row = EPI_ROW(it);
      unsigned char* g = gate_ptr(ws, br, row) + (u.pn & 3) * 256 + wc * 32 + 8 * fq;
      const float rs = rsv[it];
#pragma unroll
      for (int bj = 0; bj < 2; ++bj) {
        f32x4 v0 = acc[ai][bj][m][0] * rs, v1 = acc[ai][bj][m][1] * rs;
#pragma unroll
        for (int e = 0; e < 4; ++e) { v0[e] = sigmoidf_(v0[e]); v1[e] = sigmoidf_(v1[e]); }
        u32x2 gq; gq.x = pack4_u8(v0); gq.y = pack4_u8(v1);
        *(u32x2*)(g + bj * 128) = gq;
      }
    }
  }
};
struct EpiMerge {
  static constexpr bool CARRY = true;
  char* ws; u16* merged;
  DI void operator()(f32x4 (&acc)[2][2][4][2], const GUnit& u, int wr, int wc, int fr, int fq, const LAS float* rst) const {
    asm volatile("" : "+v"(fr), "+v"(fq));
    const int row0 = u.pm * 256 + wr * 64 + fr;
    const int br = u.tag;
    const int col = u.pn * 256 + wc * 32 + 8 * fq;
    const int brn = (br < 2) ? br + 1 : br;
    u32x2 a0, a1, b0, b1;
    {
      const unsigned char* g = gate_ptr(ws, br, EPI_ROW(0)) + col;
      a0 = *(const u32x2*)g; a1 = *(const u32x2*)(g + 128);
      const unsigned char* gn = gate_ptr(ws, brn, EPI_ROW(0)) + col;
      b0 = *(const u32x2*)gn; b1 = *(const u32x2*)(gn + 128);
    }
#pragma unroll
    for (int it = 0; it < 8; ++it) {
      const int ai = it >> 2, m = it & 3;
      const int row = EPI_ROW(it);
      u32x2 na0 = a0, na1 = a1, nb0 = b0, nb1 = b1;
      if (it + 1 < 8) {
        const unsigned char* g = gate_ptr(ws, br, EPI_ROW(it + 1)) + col;
        na0 = *(const u32x2*)g; na1 = *(const u32x2*)(g + 128);
        const unsigned char* gn = gate_ptr(ws, brn, EPI_ROW(it + 1)) + col;
        nb0 = *(const u32x2*)gn; nb1 = *(const u32x2*)(gn + 128);
      }
#pragma unroll
      for (int bj = 0; bj < 2; ++bj) {
        const u32x2 ga = bj ? a1 : a0;
        const u32x2 gb = bj ? b1 : b0;
        f32x4 f0 = unpack4_u8(ga.x), f1 = unpack4_u8(ga.y);
        if (br < 2) {
          const f32x4 d0 = unpack4_u8(gb.x), d1 = unpack4_u8(gb.y);
#pragma unroll
          for (int e = 0; e < 4; ++e) { f0[e] *= __builtin_amdgcn_rcpf(d0[e]); f1[e] *= __builtin_amdgcn_rcpf(d1[e]); }
          acc[ai][bj][m][0] *= f0; acc[ai][bj][m][1] *= f1;
        } else {
          *(u32x4*)(merged + (size_t)row * 1024 + col + bj * 128) = pack8(acc[ai][bj][m][0] * f0, acc[ai][bj][m][1] * f1);
        }
      }
      a0 = na0; a1 = na1; b0 = nb0; b1 = nb1;
    }
  }
};
struct SchedMerge {
  char* ws; int G, c;
  DI bool next(int i, GUnit& u) const {
    const int tile = i / 3, br = i - tile * 3;
    const int L = tile * G + c;
    if (L >= 512) return false;
    static_tile(L, 128, 4, u.pm, u.pn);
    u.tag = br;
    if (br == 0) { u.A = ws + OFF_QA + (size_t)u.pm * 256 * 768 * 2; u.lda = 768; u.akb = 192; u.nt = 8; u.B = ws + OFF_W + (W_PA + (size_t)u.pn * 256 * 512) * 2; }
    else if (br == 1) { u.A = ws + OFF_CQ + (size_t)u.pm * 256 * 256 * 2; u.lda = 256; u.akb = 128; u.nt = 4; u.B = ws + OFF_W + (W_PB + (size_t)u.pn * 256 * 256) * 2; }
    else { u.A = ws + OFF_QKVC + (size_t)u.pm * 256 * 64 * 2; u.lda = 64; u.akb = T * 128; u.nt = 8; u.B = ws + OFF_W + (W_PC + (size_t)u.pn * 256 * 512) * 2; }
    return true;
  }
};
struct EpiResid {
  static constexpr bool CARRY = false;
  const float* xin32; const u16* xin16; float* xout; u16* x16; float* rowsq;
  DI void operator()(f32x4 (&acc)[2][2][4][2], const GUnit& u, int wr, int wc, int fr, int fq, const LAS float* rst) const {
    asm volatile("" : "+v"(fr), "+v"(fq));
    const int row0 = u.pm * 256 + wr * 64 + fr, col0 = u.pn * 256 + wc * 32 + 4 * fq;
    f32x4 b[2][2];
#define RESID_LOAD(dst_, it_) do { const size_t o_ = (size_t)EPI_ROW(it_) * 1024 + col0; \
      _Pragma("unroll") for (int bj = 0; bj < 2; ++bj) _Pragma("unroll") for (int n = 0; n < 2; ++n) { \
        if (xin32) dst_[bj][n] = *(const f32x4*)(xin32 + o_ + bj * 128 + n * 16); \
        else { const u32x2 h_ = *(const u32x2*)(xin16 + o_ + bj * 128 + n * 16); dst_[bj][n] = (f32x4){bflo(h_.x), bfhi(h_.x), bflo(h_.y), bfhi(h_.y)}; } } } while (0)
    RESID_LOAD(b, 0);
#pragma unroll
    for (int it = 0; it < 8; ++it) {
      const int ai = it >> 2, m = it & 3;
      const int row = EPI_ROW(it);
      f32x4 nb[2][2];
#pragma unroll
      for (int bj = 0; bj < 2; ++bj)
#pragma unroll
        for (int n = 0; n < 2; ++n) nb[bj][n] = b[bj][n];
      if (it + 1 < 8) RESID_LOAD(nb, it + 1);
      const size_t off = (size_t)row * 1024 + col0;
      float ss = 0.f;
#pragma unroll
      for (int bj = 0; bj < 2; ++bj)
#pragma unroll
        for (int n = 0; n < 2; ++n) {
          const f32x4 v = b[bj][n] + acc[ai][bj][m][n];
          if (xout) *(f32x4*)(xout + off + bj * 128 + n * 16) = v;
          if (x16) { u32x2 o; o.x = pack2(v[0], v[1]); o.y = pack2(v[2], v[3]); *(u32x2*)(x16 + off + bj * 128 + n * 16) = o; }
          ss += v[0] * v[0] + v[1] * v[1] + v[2] * v[2] + v[3] * v[3];
        }
      ss = xrows_sum(ss);
      if (fq == 0) rowsq[(size_t)row * 16 + u.pn * 4 + wc] = ss;
#pragma unroll
      for (int bj = 0; bj < 2; ++bj)
#pragma unroll
        for (int n = 0; n < 2; ++n) b[bj][n] = nb[bj][n];
    }
#undef RESID_LOAD
  }
};
struct EpiNull {
  static constexpr bool CARRY = false;
  DI void operator()(f32x4 (&acc)[2][2][4][2], const GUnit& u, int wr, int wc, int fr, int fq, const LAS float* rst) const {
    if (acc[0][0][0][0][0] == 123456.789f) *(volatile float*)nullptr = acc[1][1][3][1][3];
  }
};
struct EpiFFN {
  static constexpr bool CARRY = false;
  char* ws;
  DI void operator()(f32x4 (&acc)[2][2][4][2], const GUnit& u, int wr, int wc, int fr, int fq, const LAS float* rst) const {
    asm volatile("" : "+v"(fr), "+v"(fq));
    u16* HID = (u16*)(ws + OFF_QKVB);
    const float* RSQ = (const float*)(ws + OFF_RSQ);
    const int row0 = u.pm * 256 + wr * 64 + fr, col0 = u.pn * 128 + wc * 32 + 8 * fq;
    float rsv[8];
#pragma unroll
    for (int it = 0; it < 8; ++it) rsv[it] = rst[EPI_LROW(it)];
#pragma unroll
    for (int it = 0; it < 8; ++it) {
      const int ai = it >> 2, m = it & 3;
      const float rs = rsv[it];
      f32x4 v[2];
#pragma unroll
      for (int n = 0; n < 2; ++n)
#pragma unroll
        for (int e = 0; e < 4; ++e) { const float a1 = acc[ai][0][m][n][e] * rs; v[n][e] = a1 * sigmoidf_(a1) * (acc[ai][1][m][n][e] * rs); }
#ifdef NT_STORE
      __builtin_nontemporal_store(pack8(v[0], v[1]), (u32x4*)(HID + (size_t)EPI_ROW(it) * 2816 + col0));
#else
      *(u32x4*)(HID + (size_t)EPI_ROW(it) * 2816 + col0) = pack8(v[0], v[1]);
#endif
    }
  }
};


struct EpiFFN_NoLoad {
  char* ws;
  DI void operator()(f32x4 (&acc)[2][2][4][2], const GUnit& u, int wr, int wc, int fr, int fq, const LAS float* rst) const {
    asm volatile("" : "+v"(fr), "+v"(fq));
    u16* HID = (u16*)(ws + OFF_QKVB);
    const int row0 = u.pm * 256 + wr * 64 + fr, col0 = u.pn * 128 + wc * 32 + 8 * fq;
#pragma unroll
    for (int it = 0; it < 8; ++it) {
      const int ai = it >> 2, m = it & 3;
#ifdef PROBE_HALFSTORE
      if (it & 1) continue;
#endif
#ifdef PROBE_TILED
      { const int r_ = EPI_ROW(it), c_ = u.pn * 128 + wc * 32; *(u32x4*)(HID + ((size_t)(r_ >> 4) * 88 + (c_ >> 5)) * 512 + (r_ & 15) * 32 + 8 * fq) = pack8(acc[ai][0][m][0] * acc[ai][1][m][0], acc[ai][0][m][1] * acc[ai][1][m][1]); }
#else
      *(u32x4*)(HID + (size_t)EPI_ROW(it) * 2816 + col0) = pack8(acc[ai][0][m][0] * acc[ai][1][m][0], acc[ai][0][m][1] * acc[ai][1][m][1]);
#endif
    }
  }
};

template <int MODE>
DI void attn_block(const Params& p, int l, int bidx, u16* sm, float* smf_all, u16* oalt = nullptr) {
  constexpr int DQK = (MODE == 0) ? 96 : 64;
  constexpr int KS = DQK / 16, KLD = DQK + 8, VLD = 96;
  constexpr int STG = 64 * KLD + 64 * VLD;
  constexpr int NRK = 2;
  const int t = tid_l(), lane = t & 63, w = t >> 6, l32 = lane & 31, hh = lane >> 5;
  const int half = (MODE == 0) ? 0 : (w >> 2);
  const int wl = (MODE == 0) ? w : (w & 3);
  const int tl = (MODE == 0) ? t : (t & 255);
  const int idx = (MODE == 0) ? bidx : (2 * bidx + half);
  u16* sreg = sm + half * 2 * STG;
  float* smf = smf_all + half * 512;
  char* ws = ptr_l(p.ws);
  const int kk = (MODE == 0) ? (t >> 3) : (tl >> 3);
  const int cx = (MODE == 0) ? (t & 7) : (tl & 7);
  int b, ntiles, NTL;
  u16* qptr;
  int h = 0, g = 0, hh4 = 0, dsh = 0, r = 0, mk0 = 0, L = 0, mq = 0, mq0w = 0;
  int rs0 = 0, qrow = 0, qc = 0, rsq = 0, csq = 0;
  size_t qtok;
  if (MODE == 0) {
    const int qblk = idx & 31; h = (idx >> 5) & 7; b = idx >> 8;
    qtok = (size_t)b * SEQ + qblk * 256 + w * 32 + l32;
    qptr = (u16*)(ws + OFF_QA) + qtok * 768 + h * 96;
    ntiles = 128; NTL = 128;
  } else if (MODE == 1) {
    const int sub = idx & 63; hh4 = (idx >> 6) & 3; g = (idx >> 8) % 3; b = idx / 768;
    dsh = 2 * g; L = SEQ >> dsh;
    const int nqb_sh = 6 - dsh;
    r = sub >> nqb_sh;
    const int qb = sub & ((1 << nqb_sh) - 1);
    h = g * 4 + hh4;
    mq0w = qb * 128 + wl * 32;
    mq = mq0w + l32;
    mk0 = qb * 128 - 64;
    qtok = (size_t)b * SEQ + ((size_t)mq << dsh) + r;
    qptr = (u16*)(ws + OFF_QKVB) + ((size_t)h * T + (size_t)b * SEQ + (size_t)r * L + mq) * 64;
    ntiles = 4; NTL = 4;
  } else {
    const int rp = idx & 63; h = (idx >> 6) & 7; b = idx >> 9;
    qrow = 2 * rp + (wl >> 1); qc = (wl & 1) * 32 + l32;
    qtok = (size_t)b * SEQ + qrow * 64 + qc;
    qptr = (u16*)(ws + OFF_QKVC) + ((size_t)h * T + qtok) * 64;
    rs0 = min(max(2 * rp - 4, 0), 120);
    const int rs1 = min(max(2 * rp + 1 - 4, 0), 120);
    ntiles = rs1 + 8 - rs0; NTL = 9;
    rsq = min(max(qrow - 4, 0), 120);
    csq = min(max(qc - 8, 0), 48);
  }
  float* tb = (float*)((char*)sm + 90112 + half * 8192);
  if (MODE == 2) {
    const float* rp_ = p.rpb + (size_t)(l * 8 + h) * 465;
    for (int i = tl; i < 465; i += 256) { const int r_ = i / 31, j_ = i - r_ * 31; tb[r_ * 128 + 49 + j_] = rp_[i] * LOG2E; }
  }
  bf16x8 qf[KS];
#pragma unroll
  for (int ks = 0; ks < KS; ++ks) qf[ks] = *(const bf16x8*)(qptr + ks * 16 + hh * 8);

  constexpr int NTLC = (MODE == 1) ? 4 : 9;
  u32x4 st_[2][4], x_[4];
#define LOAD_TILE(tt_, D_) do { \
    if (MODE == 1) { \
      int mka_ = mk0 + (tt_) * 64 + kk, mkb_ = mka_ + 32; mka_ = min(max(mka_, 0), L - 1); mkb_ = min(max(mkb_, 0), L - 1); \
      const u16* ba_ = (const u16*)(ws + OFF_QKVB) + ((size_t)(12 + h) * T + (size_t)b * SEQ + (size_t)r * L + mka_) * 64 + cx * 8; \
      const u16* bb_ = (const u16*)(ws + OFF_QKVB) + ((size_t)(12 + h) * T + (size_t)b * SEQ + (size_t)r * L + mkb_) * 64 + cx * 8; \
      D_[0] = *(const u32x4*)(ba_); D_[1] = *(const u32x4*)(bb_); \
      D_[2] = *(const u32x4*)(ba_ + (size_t)12 * T * 64); D_[3] = *(const u32x4*)(bb_ + (size_t)12 * T * 64); \
    } else { \
      const u16* ba_ = (const u16*)(ws + OFF_QKVC) + ((size_t)(8 + h) * T + (size_t)b * SEQ + (rs0 + min((tt_), ntiles - 1)) * 64 + kk) * 64 + cx * 8; \
      D_[0] = *(const u32x4*)(ba_); D_[1] = *(const u32x4*)(ba_ + 32 * 64); \
      D_[2] = *(const u32x4*)(ba_ + (size_t)8 * T * 64); D_[3] = *(const u32x4*)(ba_ + (size_t)8 * T * 64 + 32 * 64); \
    } } while (0)
#define STORE_TILE(stg_, S_) do { \
    u16* sK_ = sreg + (stg_) * STG; u16* sV_ = sK_ + 64 * KLD; \
    *(u32x4*)(sK_ + kk * KLD + cx * 8) = S_[0]; *(u32x4*)(sK_ + (kk + 32) * KLD + cx * 8) = S_[1]; \
    *(u32x4*)(sV_ + kk * VLD + cx * 8) = S_[2]; *(u32x4*)(sV_ + (kk + 32) * VLD + cx * 8) = S_[3]; } while (0)
  LOAD_TILE(0, x_); LOAD_TILE(1, st_[0]); LOAD_TILE(2, st_[1]);
  STORE_TILE(0, x_);
  __syncthreads();

  f32x16 o[2];
#pragma unroll
  for (int i = 0; i < 16; ++i) { o[0][i] = 0.f; o[1][i] = 0.f; }
  float m_run = -1e30f, l_run = 0.f;
  const int li = lane & 15, qd = li >> 2, pp = li & 3, dblk = (lane >> 4) & 1;
  const int voff = (4 * hh + qd) * VLD + 16 * dblk + 4 * pp;

#pragma unroll
  for (int tt = 0; tt < NTLC; ++tt) {
    if (tt + 1 < NTLC) { STORE_TILE((tt + 1) & 1, st_[tt % 2]); if (tt + 3 < NTLC) LOAD_TILE(tt + 3, st_[tt % 2]); }
    const u16* sK = sreg + (tt & 1) * STG;
    const u16* sV = sK + 64 * KLD;
    bool active = true;
    if (MODE == 1) {
      const int klo = mk0 + tt * 64;
      active = !(klo + 63 < mq0w - 64 || klo > mq0w + 95);
    } else if (MODE == 2) {
      const int krow = rs0 + tt;
      active = (krow >= rsq) && (krow < rsq + 8);
    }
    if (active) {
      f32x16 s[2];
      bf16x8 kf[KS][2];
#pragma unroll
      for (int ks = 0; ks < KS; ++ks)
#pragma unroll
        for (int k2 = 0; k2 < 2; ++k2) kf[ks][k2] = *(const bf16x8*)(sK + (k2 * 32 + l32) * KLD + ks * 16 + hh * 8);
      s16x4 vlo[2][2][2], vhi[2][2][2];
#pragma unroll
      for (int k2 = 0; k2 < 2; ++k2)
#pragma unroll
        for (int s2 = 0; s2 < 2; ++s2)
#pragma unroll
          for (int dt = 0; dt < 2; ++dt) {
            const u16* va = sV + (k2 * 32 + 16 * s2) * VLD + voff + dt * 32;
            vlo[k2][s2][dt] = __builtin_amdgcn_ds_read_tr16_b64_v4i16((s16x4 LAS*)(va));
            vhi[k2][s2][dt] = __builtin_amdgcn_ds_read_tr16_b64_v4i16((s16x4 LAS*)(va + 8 * VLD));
          }
#pragma unroll
      for (int k2 = 0; k2 < 2; ++k2)
#pragma unroll
        for (int i = 0; i < 16; ++i) s[k2][i] = 0.f;
#pragma unroll
      for (int ks = 0; ks < KS; ++ks)
#pragma unroll
        for (int k2 = 0; k2 < 2; ++k2) s[k2] = MFMA(kf[ks][k2], qf[ks], s[k2]);
      if (MODE == 1) {
        const int klo = mk0 + tt * 64;
        const int db = klo + 4 * hh - mq + 64;
        const bool edge = (klo < 0) || (klo + 63 >= L);
        if (!edge) {
#pragma unroll
          for (int k2 = 0; k2 < 2; ++k2)
#pragma unroll
            for (int i = 0; i < 16; ++i) {
              const int ci = k2 * 32 + (i & 3) + 8 * (i >> 2);
              s[k2][i] = ((unsigned)(db + ci) <= 128u) ? s[k2][i] : -INFINITY;
            }
        } else {
          const int mb = klo + 4 * hh;
#pragma unroll
          for (int k2 = 0; k2 < 2; ++k2)
#pragma unroll
            for (int i = 0; i < 16; ++i) {
              const int ci = k2 * 32 + (i & 3) + 8 * (i >> 2);
              const bool valid = ((unsigned)(db + ci) <= 128u) && ((unsigned)(mb + ci) < (unsigned)L);
              s[k2][i] = valid ? s[k2][i] : -INFINITY;
            }
        }
      } else if (MODE == 2) {
        const float* tp = tb + (rs0 + tt - qrow + 7) * 128 + 64 + 4 * hh - qc;
        const int e0 = 4 * hh - csq;
        float bv[2][16];
#pragma unroll
        for (int k2 = 0; k2 < 2; ++k2)
#pragma unroll
          for (int i = 0; i < 16; ++i) bv[k2][i] = tp[k2 * 32 + (i & 3) + 8 * (i >> 2)];
#pragma unroll
        for (int k2 = 0; k2 < 2; ++k2)
#pragma unroll
          for (int i = 0; i < 16; ++i) {
            const int ci = k2 * 32 + (i & 3) + 8 * (i >> 2);
            const float sb = s[k2][i] + bv[k2][i];
            s[k2][i] = ((unsigned)(ci + e0) < 16u) ? sb : -INFINITY;
          }
      }
      float mx = s[0][0];
#pragma unroll
      for (int i = 1; i < 16; ++i) mx = fmaxf(mx, s[0][i]);
#pragma unroll
      for (int i = 0; i < 16; ++i) mx = fmaxf(mx, s[1][i]);
      mx = xhalf_max(mx);
      const float mnew = fmaxf(m_run, mx);
      const float alpha = __builtin_amdgcn_exp2f(m_run - mnew);
      m_run = mnew;
      float ps = 0.f;
#pragma unroll
      for (int k2 = 0; k2 < 2; ++k2)
#pragma unroll
        for (int i = 0; i < 16; ++i) { s[k2][i] = __builtin_amdgcn_exp2f(s[k2][i] - mnew); ps += s[k2][i]; }
      l_run = l_run * alpha + ps;
#pragma unroll
      for (int i = 0; i < 16; ++i) { o[0][i] *= alpha; o[1][i] *= alpha; }
#pragma unroll
      for (int k2 = 0; k2 < 2; ++k2)
#pragma unroll
        for (int s2 = 0; s2 < 2; ++s2) {
          u32x4 u;
          u.x = pack2(s[k2][8 * s2 + 0], s[k2][8 * s2 + 1]); u.y = pack2(s[k2][8 * s2 + 2], s[k2][8 * s2 + 3]);
          u.z = pack2(s[k2][8 * s2 + 4], s[k2][8 * s2 + 5]); u.w = pack2(s[k2][8 * s2 + 6], s[k2][8 * s2 + 7]);
          const bf16x8 pf = __builtin_bit_cast(bf16x8, u);
#pragma unroll
          for (int dt = 0; dt < 2; ++dt) {
            const bf16x8 vf = __builtin_shufflevector(vlo[k2][s2][dt], vhi[k2][s2][dt], 0, 1, 2, 3, 4, 5, 6, 7);
            o[dt] = MFMA(vf, pf, o[dt]);
          }
        }
    }
    __syncthreads();
  }
#undef LOAD_TILE
#undef STORE_TILE
  const float l_tot = xhalf_sum(l_run);
  const float inv = __builtin_amdgcn_rcpf(l_tot);
#pragma unroll
  for (int dt = 0; dt < 2; ++dt)
#pragma unroll
    for (int rg = 0; rg < 4; ++rg) {
      u32x2 u;
      u.x = pack2(o[dt][4 * rg] * inv, o[dt][4 * rg + 1] * inv);
      u.y = pack2(o[dt][4 * rg + 2] * inv, o[dt][4 * rg + 3] * inv);
      u16* op_ = !oalt ? qptr : (MODE == 0 ? (oalt + qtok * 768 + h * 96) : (MODE == 1 ? (oalt + qtok * 768 + h * 64) : (oalt + (size_t)T * 768 + qtok * 512 + h * 64)));
      *(u32x2*)(op_ + dt * 32 + 8 * rg + 4 * hh) = u;
    }
  if (MODE == 1) {
    if (hh == 0) {
      float* LB = (float*)(ws + OFF_CKV);
      LB[((size_t)g * T + qtok) * 4 + hh4] = m_run * LN2 + __logf(l_tot);
    }
  }
}

#ifndef MLA_THR
#define MLA_THR 8.f
#endif
DI void attn_mla(const Params& p, int idx, u16* sm, u16* oalt) {
  constexpr int KS = 6, KLD = 104, VLD = 96, NTL = 128, KST = 64 * KLD, VST = 64 * VLD;
  u16* sKr = sm;
  u16* sVr = sm + 4 * KST;
  const int t = tid_l(), lane = t & 63, w = t >> 6, l32 = lane & 31, hh = lane >> 5;
  char* ws = ptr_l(p.ws);
  const int kk = t >> 3, cx = t & 7;
  const int qblk = idx & 31, h = (idx >> 5) & 7, b = idx >> 8;
  const size_t qtok = (size_t)b * SEQ + qblk * 256 + w * 32 + l32;
  u16* qptr = (u16*)(ws + OFF_QA) + qtok * 768 + h * 96;
  bf16x8 qf[KS];
#pragma unroll
  for (int ks = 0; ks < KS; ++ks) qf[ks] = *(const bf16x8*)(qptr + ks * 16 + hh * 8);
  const u16* kvbase = (const u16*)(ws + OFF_KVA) + ((size_t)b * SEQ + kk) * 1024 + h * 128;
  const u16* krbase = (const u16*)(ws + OFF_KROPE) + ((size_t)b * SEQ + kk) * 32;
#define MLA_LD(tk_, tv_, k0_, k1_, v0_) do { \
    k0_ = *(const u32x4*)(kvbase + (size_t)(tk_) * 64 * 1024 + cx * 8); \
    k1_ = *(const u32x4*)(krbase + (size_t)(tk_) * 64 * 32 + (cx & 3) * 8); \
    v0_ = *(const u32x4*)(kvbase + (size_t)(tv_) * 64 * 1024 + 64 + cx * 8); } while (0)
#define MLA_STK(sk_, k0_, k1_) do { u16* sK_ = sKr + (sk_) * KST; \
    *(u32x4*)(sK_ + kk * KLD + cx * 8) = k0_; \
    *(u32x4*)(sK_ + kk * KLD + 64 + (cx & 3) * 8) = k1_; } while (0)
#define MLA_STV(sv_, v0_) do { *(u32x4*)(sVr + (sv_) * VST + kk * VLD + cx * 8) = v0_; } while (0)
  u32x4 ck0, ck1, cv0, nk0, nk1, nv0;
  {
    u32x4 a0, a1, a2, b0, b1, b2;
    MLA_LD(0, 0, a0, a1, a2); MLA_LD(1, 1, b0, b1, cv0); MLA_LD(2, 1, nk0, nk1, b2); MLA_LD(3, 1, ck0, ck1, nv0);
    MLA_STK(0, a0, a1); MLA_STV(0, a2); MLA_STK(1, b0, b1); MLA_STK(2, nk0, nk1);
    unsigned zz = 0u; asm volatile("" : "+v"(zz));
    MLA_STV(3, ((u32x4){zz, zz, zz, zz}));
  }
  __syncthreads();
  const int li = lane & 15, qd = li >> 2, pp_ = li & 3, dblk = (lane >> 4) & 1;
  const int voff = (4 * hh + qd) * VLD + 16 * dblk + 4 * pp_;
  const int koff = l32 * KLD + hh * 8;
  f32x16 o[2], sA[2], sB[2], mneg;
#pragma unroll
  for (int i = 0; i < 16; ++i) { o[0][i] = 0.f; o[1][i] = 0.f; sA[0][i] = 0.f; sA[1][i] = 0.f; }
#pragma unroll
  for (int ks = 0; ks < KS; ++ks)
#pragma unroll
    for (int k2 = 0; k2 < 2; ++k2) sA[k2] = MFMA(*(const bf16x8*)(sKr + k2 * 32 * KLD + koff + ks * 16), qf[ks], sA[k2]);
  float m_run, l_run = 0.f;
  {
    float mx = sA[0][0];
#pragma unroll
    for (int i = 1; i < 16; ++i) mx = fmaxf(mx, sA[0][i]);
#pragma unroll
    for (int i = 0; i < 16; ++i) mx = fmaxf(mx, sA[1][i]);
    mx = xhalf_max(mx);
    m_run = mx;
#pragma unroll
    for (int i = 0; i < 16; ++i) { sA[0][i] -= mx; sA[1][i] -= mx; mneg[i] = -mx; }
  }
  bf16x8 pp[4];
#pragma unroll
  for (int i = 0; i < 4; ++i) { unsigned zq = 0u; asm volatile("" : "+v"(zq)); pp[i] = __builtin_bit_cast(bf16x8, ((u32x4){zq, zq, zq, zq})); }

#define MLA_BODY(tt, SIN, SOUT, LK0, LK1, LV0, SK0, SK1, SV0) do { \
    { const int tk_ = min((tt) + 4, NTL - 1), tv_ = min((tt) + 2, NTL - 1); MLA_LD(tk_, tv_, LK0, LK1, LV0); } \
    float mx = SIN[0][0]; \
    _Pragma("unroll") for (int i = 1; i < 16; ++i) mx = fmaxf(mx, SIN[0][i]); \
    _Pragma("unroll") for (int i = 0; i < 16; ++i) mx = fmaxf(mx, SIN[1][i]); \
    mx = xhalf_max(mx); \
    if (!__all(mx <= MLA_THR)) { \
      const float dm = fmaxf(mx, 0.f); \
      const float alpha = __builtin_amdgcn_exp2f(-dm); \
      m_run += dm; l_run *= alpha; \
      _Pragma("unroll") for (int i = 0; i < 16; ++i) { o[0][i] *= alpha; o[1][i] *= alpha; SIN[0][i] -= dm; SIN[1][i] -= dm; mneg[i] = -m_run; } \
      _Pragma("unroll") for (int q_ = 0; q_ < 4; ++q_) { \
        u32x4 u_ = __builtin_bit_cast(u32x4, pp[q_]); \
        u_.x = pack2(bflo(u_.x) * alpha, bfhi(u_.x) * alpha); u_.y = pack2(bflo(u_.y) * alpha, bfhi(u_.y) * alpha); \
        u_.z = pack2(bflo(u_.z) * alpha, bfhi(u_.z) * alpha); u_.w = pack2(bflo(u_.w) * alpha, bfhi(u_.w) * alpha); \
        pp[q_] = __builtin_bit_cast(bf16x8, u_); } \
    } \
    const u16* sK = sKr + (((tt) + 1) & 3) * KST + koff; \
    const u16* sV = sVr + (((tt) + 3) & 3) * VST + voff; \
    _Pragma("unroll") for (int k2 = 0; k2 < 2; ++k2) \
      _Pragma("unroll") for (int s2 = 0; s2 < 2; ++s2) \
        _Pragma("unroll") for (int dt = 0; dt < 2; ++dt) { \
          const u16* va = sV + (k2 * 32 + 16 * s2) * VLD + dt * 32; \
          const s16x4 lo = __builtin_amdgcn_ds_read_tr16_b64_v4i16((s16x4 LAS*)(va)); \
          const s16x4 hi = __builtin_amdgcn_ds_read_tr16_b64_v4i16((s16x4 LAS*)(va + 8 * VLD)); \
          o[dt] = MFMA(__builtin_shufflevector(lo, hi, 0, 1, 2, 3, 4, 5, 6, 7), pp[k2 * 2 + s2], o[dt]); \
        } \
    _Pragma("unroll") for (int k2 = 0; k2 < 2; ++k2) SOUT[k2] = MFMA(*(const bf16x8*)(sK + k2 * 32 * KLD), qf[0], mneg); \
    _Pragma("unroll") for (int ks = 1; ks < KS; ++ks) \
      _Pragma("unroll") for (int k2 = 0; k2 < 2; ++k2) SOUT[k2] = MFMA(*(const bf16x8*)(sK + k2 * 32 * KLD + ks * 16), qf[ks], SOUT[k2]); \
    float ps = 0.f; \
    _Pragma("unroll") for (int k2 = 0; k2 < 2; ++k2) \
      _Pragma("unroll") for (int i = 0; i < 16; ++i) { SIN[k2][i] = __builtin_amdgcn_exp2f(SIN[k2][i]); ps += SIN[k2][i]; } \
    l_run += ps; \
    _Pragma("unroll") for (int k2 = 0; k2 < 2; ++k2) \
      _Pragma("unroll") for (int s2 = 0; s2 < 2; ++s2) { \
        u32x4 u_; \
        u_.x = pack2(SIN[k2][8 * s2 + 0], SIN[k2][8 * s2 + 1]); u_.y = pack2(SIN[k2][8 * s2 + 2], SIN[k2][8 * s2 + 3]); \
        u_.z = pack2(SIN[k2][8 * s2 + 4], SIN[k2][8 * s2 + 5]); u_.w = pack2(SIN[k2][8 * s2 + 6], SIN[k2][8 * s2 + 7]); \
        pp[k2 * 2 + s2] = __builtin_bit_cast(bf16x8, u_); } \
    MLA_STK(((tt) + 3) & 3, SK0, SK1); MLA_STV(((tt) + 1) & 3, SV0); \
    __builtin_amdgcn_sched_group_barrier(0x100, 4, 0); \
    _Pragma("unroll") for (int g_ = 0; g_ < 20; ++g_) { __builtin_amdgcn_sched_group_barrier(0x008, 1, 0); __builtin_amdgcn_sched_group_barrier(0x100, 2, 0); __builtin_amdgcn_sched_group_barrier(0x402, 6, 0); } \
    __syncthreads(); \
  } while (0)
  for (int t2 = 0; t2 < NTL; t2 += 2) {
    MLA_BODY(t2, sA, sB, nk0, nk1, nv0, ck0, ck1, cv0);
    MLA_BODY(t2 + 1, sB, sA, ck0, ck1, cv0, nk0, nk1, nv0);
  }
#undef MLA_BODY
#undef MLA_LD
#undef MLA_STK
#undef MLA_STV
  {
    const u16* sV = sVr + 3 * VST + voff;
#pragma unroll
    for (int k2 = 0; k2 < 2; ++k2)
#pragma unroll
      for (int s2 = 0; s2 < 2; ++s2)
#pragma unroll
        for (int dt = 0; dt < 2; ++dt) {
          const u16* va = sV + (k2 * 32 + 16 * s2) * VLD + dt * 32;
          const s16x4 lo = __builtin_amdgcn_ds_read_tr16_b64_v4i16((s16x4 LAS*)(va));
          const s16x4 hi = __builtin_amdgcn_ds_read_tr16_b64_v4i16((s16x4 LAS*)(va + 8 * VLD));
          o[dt] = MFMA(__builtin_shufflevector(lo, hi, 0, 1, 2, 3, 4, 5, 6, 7), pp[k2 * 2 + s2], o[dt]);
        }
  }
  __syncthreads();
  const float l_tot = xhalf_sum(l_run);
  const float inv = __builtin_amdgcn_rcpf(l_tot);
  u16* op_ = oalt ? (oalt + qtok * 768 + h * 96) : qptr;
#pragma unroll
  for (int dt = 0; dt < 2; ++dt)
#pragma unroll
    for (int rg = 0; rg < 4; ++rg) {
      u32x2 u;
      u.x = pack2(o[dt][4 * rg] * inv, o[dt][4 * rg + 1] * inv);
      u.y = pack2(o[dt][4 * rg + 2] * inv, o[dt][4 * rg + 3] * inv);
      *(u32x2*)(op_ + dt * 32 + 8 * rg + 4 * hh) = u;
    }
}

DI void phase_attn(const Params& p, int l, u16* sm, float* smf, int probe = 0) {
#ifdef ATTN_TRUE_XCC
  const int G = gdim_l(), bid = bid_l();
#else
  int bid = blockIdx.x; asm volatile("" : "+s"(bid));
  const int G = gdim_l();
#endif
  {
    const int x = bid & 7, G8 = G >> 3;
    if (probe != 2) for (int j = bid >> 3; j < 128; j += G8) {
      const int pair = x * 4 + (j >> 5);
      attn_mla(p, pair * 32 + (j & 31), sm, probe ? (u16*)p.out : nullptr);
    }
  }
  if (probe == 1) return;
  for (int bi = bid; bi < 1536 + 1024; bi += G) {
    if (bi < 1536) attn_block<1>(p, l, bi, sm, smf, probe ? (u16*)p.out : nullptr);
    else attn_block<2>(p, l, bi - 1536, sm, smf, probe ? (u16*)p.out : nullptr);
  }
}

DI void phase_dilmerge(const Params& p) {
  char* ws = ptr_l(p.ws);
  const u16* QKVB = (const u16*)(ws + OFF_QKVB);
  const float* LB = (const float*)(ws + OFF_CKV);
  u16* YB = (u16*)(ws + OFF_CQ);
  const int stride = gdim_l() * NT;
  for (int i = bid_l() * NT + tid_l(); i < T * 32; i += stride) {
    const int tok = i >> 5, c = i & 31, hh4 = c >> 3;
    float ls[3];
#pragma unroll
    for (int g = 0; g < 3; ++g) ls[g] = LB[((size_t)g * T + tok) * 4 + hh4];
    const float mx = fmaxf(ls[0], fmaxf(ls[1], ls[2]));
    float a[3]; float sum = 0.f;
#pragma unroll
    for (int g = 0; g < 3; ++g) { a[g] = __expf(ls[g] - mx); sum += a[g]; }
    const float inv = __builtin_amdgcn_rcpf(sum);
    float acc[8];
#pragma unroll
    for (int j = 0; j < 8; ++j) acc[j] = 0.f;
#pragma unroll
    for (int g = 0; g < 3; ++g) {
      const u32x4 v = *(const u32x4*)(QKVB + ((size_t)(g * 4 + hh4) * T + dil_row(tok, 2 * g)) * 64 + (c & 7) * 8);
      const float al = a[g] * inv;
      acc[0] += al * bflo(v.x); acc[1] += al * bfhi(v.x); acc[2] += al * bflo(v.y); acc[3] += al * bfhi(v.y);
      acc[4] += al * bflo(v.z); acc[5] += al * bfhi(v.z); acc[6] += al * bflo(v.w); acc[7] += al * bfhi(v.w);
    }
    u32x4 o;
    o.x = pack2(acc[0], acc[1]); o.y = pack2(acc[2], acc[3]); o.z = pack2(acc[4], acc[5]); o.w = pack2(acc[6], acc[7]);
    *(u32x4*)(YB + (size_t)tok * 256 + c * 8) = o;
  }
}

__global__ void __launch_bounds__(NT, 2) mk_forward(Params p) {
  cg::grid_group grid = cg::this_grid();
#define GSYNC() xcd_barrier(xb)
  __shared__ __attribute__((aligned(16))) unsigned char lds_all[131072 + 4096];
  LAS unsigned char* lds = (LAS unsigned char*)lds_all;
  u16* sm = (u16*)lds_all;
  float* smf = (float*)(lds_all + 131072);
  volatile LAS unsigned* xst = (volatile LAS unsigned*)(lds_all + 131072 + 4096 - 32);
  if (threadIdx.x == 0) { xst[0] = 0u; xst[1] = 0u; }
  __syncthreads();
  const XcdBarrier xb = xcd_barrier_post((unsigned*)(p.ws + OFF_BAR), xst);
#pragma unroll 1
  for (int l = 0; l < 2; ++l) {
    const int G = gdim_l();
    char* ws = ptr_l(p.ws);
    const float* xin = (l == 0) ? p.x : p.out;
    conv_layer(p, l, sm);
    float* PA = (float*)(ws + OFF_PA); float* PB = (float*)(ws + OFF_PB);
    if (l == 0) { rope_tables(p); x16_rows(p.x, (u16*)(ws + OFF_H), PA); }
    if (l == 0) grid.sync(); else GSYNC();
#if defined(GEMM_TRUE_XCC)
    const int c = bid_l();
#elif defined(GEMM_CHUNK_XCC)
    const int vb_ = bid_l(); const int c = (vb_ & 7) * 32 + (vb_ >> 3);
#else
    int c = blockIdx.x; asm volatile("" : "+s"(c));
#endif
    {
      SchedSimple S{ws + OFF_H, ws + OFF_W + W_IN * 2, 1024, 128, 16, 17, G, c};
      gemm_phase<true, true, true>(lds, S, EpiP1{ws}, PA, 1.f / 1024.f, 4);
    }
    GSYNC();
    {
      SchedSimple Sq{ws + OFF_CQ, ws + OFF_W + W_UQ * 2, 256, 128, 4, 3, G, c};
      gemm_phase<true, true, true>(lds, Sq, EpiP2q{ws}, (const float*)(ws + OFF_PQ), 1.f / 256.f, 1);
      SchedSimple Skv{ws + OFF_CKV, ws + OFF_W + W_UKV * 2, 128, 128, 2, 4, G, c};
      gemm_phase<true, true, false>(lds, Skv, EpiP2kv{ws});
    }
    GSYNC();
    phase_attn(p, l, sm, smf);
    GSYNC();
    phase_dilmerge(p);
    {
      SchedSimple S{ws + OFF_H, ws + OFF_W + W_G * 2, 1024, 128, 16, 12, G, c};
      gemm_phase<true, true, true>(lds, S, EpiGate{ws}, PA, 1.f / 1024.f, 4);
    }
    GSYNC();
    {
      SchedMerge S{ws, G, c};
      gemm_phase<true, false, false>(lds, S, EpiMerge{ws, (u16*)p.out});
    }
    GSYNC();
    {
      SchedSimple S{(const char*)p.out, ws + OFF_W + W_O * 2, 1024, 128, 16, 4, G, c};
      gemm_phase<false, true, false>(lds, S, EpiResid{(l == 0) ? p.x : nullptr, (l == 0) ? nullptr : (const u16*)(ws + OFF_H), nullptr, (u16*)(ws + OFF_KVA), PB});
    }
    GSYNC();
    {
      SchedSimple S{ws + OFF_KVA, ws + OFF_W + W_13 * 2, 1024, 128, 16, 22, G, c};
      gemm_phase<true, true, true>(lds, S, EpiFFN{ws}, PB, 1.f / 1024.f, 4);
#ifdef PROBE_FFN
      GSYNC(); gemm_phase<true, true, true>(lds, S, EpiFFN{ws}, PB, 1.f / 1024.f, 4);
#endif
#ifdef PROBE_FFN_NOLOAD
      GSYNC(); gemm_phase<true, true, false>(lds, S, EpiFFN_NoLoad{ws}); GSYNC(); gemm_phase<true, true, true>(lds, S, EpiFFN{ws}, PB, 1.f / 1024.f, 4);
#endif
#ifdef PROBE_FFN_NULL
      GSYNC(); gemm_phase<true, true, false>(lds, S, EpiNull{});
#endif
    }
    GSYNC();
    {
      SchedSimple S{ws + OFF_QKVB, ws + OFF_W + W_2 * 2, 2816, 128, 44, 4, G, c};
      gemm_phase<false, true, false>(lds, S, EpiResid{nullptr, (const u16*)(ws + OFF_KVA), (l == 1) ? p.out : nullptr, (l == 1) ? nullptr : (u16*)(ws + OFF_H), PA});
    }
    GSYNC();
  }
  scale_rows_f32(p.out, (const float*)(p.ws + OFF_PA), p.g_final);
}

extern "C" void kernel_launch(void* const* d_in, const int* in_sizes, int n_in, void* d_out, int out_size, void* d_ws,
                              size_t ws_size, hipStream_t stream) {
  static int grid_blocks = 0;
  if (!grid_blocks) {
    int dev = 0, cus = 0, per_cu = 0;
    (void)hipGetDevice(&dev);
    (void)hipDeviceGetAttribute(&cus, hipDeviceAttributeMultiprocessorCount, dev);
    (void)hipOccupancyMaxActiveBlocksPerMultiprocessor(&per_cu, mk_forward, NT, 0);
    if (per_cu < 1) per_cu = 1;
    grid_blocks = cus;
    if (grid_blocks > 256) grid_blocks = 256;
  }
  Params p{};
  p.x = (const float*)d_in[0]; p.w_in = (const float*)d_in[1]; p.g_mix = (const float*)d_in[2];
  p.g_q = (const float*)d_in[3]; p.g_kv = (const float*)d_in[4]; p.w_uq = (const float*)d_in[5];
  p.w_ukv = (const float*)d_in[6]; p.rpb = (const float*)d_in[7]; p.w_pa = (const float*)d_in[8];
  p.w_pb = (const float*)d_in[9]; p.w_pc = (const float*)d_in[10]; p.w_o = (const float*)d_in[11];
  p.g_ffn = (const float*)d_in[12]; p.w1 = (const float*)d_in[13]; p.w3 = (const float*)d_in[14];
  p.w2 = (const float*)d_in[15]; p.g_final = (const float*)d_in[16];
  p.out = (float*)d_out;
  p.ws = (char*)d_ws;
  (void)hipMemsetAsync((char*)d_ws + OFF_BAR, 0, XCD_BAR_WORDS * 4, stream);
  void* args[] = {&p};
  hipError_t e = hipLaunchCooperativeKernel((void*)mk_forward, dim3(grid_blocks), dim3(NT), args, 0, stream);
  if (e != hipSuccess) fprintf(stderr, "cooperative launch failed: %s (grid %d)\n", hipGetErrorString(e), grid_blocks);
}
```

```cpp
#include <hip/hip_runtime.h>
#include <hip/hip_cooperative_groups.h>
#include <cstdio>
namespace cg = cooperative_groups;

typedef unsigned short u16;
typedef __attribute__((ext_vector_type(8))) short bf16x8;
typedef __attribute__((ext_vector_type(4))) short s16x4;
typedef __attribute__((ext_vector_type(16))) float f32x16;
typedef __attribute__((ext_vector_type(4))) float f32x4;
typedef __attribute__((ext_vector_type(2))) __bf16 bf16v2;
typedef __attribute__((ext_vector_type(4))) unsigned u32x4;
typedef __attribute__((ext_vector_type(2))) unsigned u32x2;
#define DI __device__ __forceinline__
#define LAS __attribute__((address_space(3)))
#define MFMA(a, b, c) __builtin_amdgcn_mfma_f32_32x32x16_bf16((a), (b), (c), 0, 0, 0)

constexpr int NT = 512;
constexpr int T = 32768;
constexpr int SEQ = 8192;
constexpr float LOG2E = 1.4426950408889634f;
constexpr float LN2 = 0.6931471805599453f;
constexpr float EPS = 1e-6f;

constexpr size_t MiB = 1024ull * 1024ull;
constexpr size_t OFF_W = 0;
constexpr size_t OFF_CS64 = 40 * MiB;
constexpr size_t OFF_CS32 = 42 * MiB;
constexpr size_t OFF_RSQ = 43 * MiB;
constexpr size_t OFF_BAR = 43 * MiB + 512 * 1024;
constexpr size_t OFF_H = 44 * MiB;
constexpr size_t OFF_CQ = 108 * MiB;
constexpr size_t OFF_CKV = 124 * MiB;
constexpr size_t OFF_KROPE = 132 * MiB;
constexpr size_t OFF_QA = 134 * MiB;
constexpr size_t OFF_KVA = 182 * MiB;
constexpr size_t OFF_QKVB = 246 * MiB;
constexpr size_t OFF_QKVC = 390 * MiB;
constexpr size_t OFF_PQ = 486 * MiB;
constexpr size_t OFF_PKV = 486 * MiB + 512 * 1024;
constexpr size_t OFF_PA = 487 * MiB;
constexpr size_t OFF_PB = 489 * MiB;
constexpr size_t W_IN = 0;
constexpr size_t W_G = W_IN + 4352ull * 1024;
constexpr size_t W_UQ = W_G + 3072ull * 1024;
constexpr size_t W_UKV = W_UQ + 768ull * 256;
constexpr size_t W_PA = W_UKV + 1024ull * 128;
constexpr size_t W_PB = W_PA + 1024ull * 512;
constexpr size_t W_PC = W_PB + 1024ull * 256;
constexpr size_t W_O = W_PC + 1024ull * 512;
constexpr size_t W_13 = W_O + 1024ull * 1024;
constexpr size_t W_2 = W_13 + 5632ull * 1024;

struct Params {
  const float *x, *w_in, *g_mix, *g_q, *g_kv, *w_uq, *w_ukv, *rpb, *w_pa, *w_pb, *w_pc, *w_o, *g_ffn, *w1, *w3, *w2, *g_final;
  float* out;
  char* ws;
};

DI unsigned pack2(float a, float b) {
  bf16v2 v; v[0] = (__bf16)a; v[1] = (__bf16)b;
  return __builtin_bit_cast(unsigned, v);
}
DI u16 f2bf(float a) { return __builtin_bit_cast(u16, (__bf16)a); }
DI float bflo(unsigned u) { return __uint_as_float(u << 16); }
DI float bfhi(unsigned u) { return __uint_as_float(u & 0xffff0000u); }
DI int tid_l() { int t = threadIdx.x; asm volatile("" : "+v"(t)); return t; }
DI int gdim_l() { int g = gridDim.x; asm volatile("" : "+s"(g)); return g; }
DI float shx(float v, int m, int lane) { return __int_as_float(__builtin_amdgcn_ds_bpermute((lane ^ m) << 2, __float_as_int(v))); }
DI float xhalf_max(float v) {
  const auto r = __builtin_amdgcn_permlane32_swap(__float_as_uint(v), __float_as_uint(v), false, false);
  return fmaxf(__uint_as_float(r[0]), __uint_as_float(r[1]));
}
DI float xhalf_sum(float v) {
  const auto r = __builtin_amdgcn_permlane32_swap(__float_as_uint(v), __float_as_uint(v), false, false);
  return __uint_as_float(r[0]) + __uint_as_float(r[1]);
}
DI float xrows_sum(float v) {
  const auto a = __builtin_amdgcn_permlane16_swap(__float_as_uint(v), __float_as_uint(v), false, false);
  const float s = __uint_as_float(a[0]) + __uint_as_float(a[1]);
  const auto b = __builtin_amdgcn_permlane32_swap(__float_as_uint(s), __float_as_uint(s), false, false);
  return __uint_as_float(b[0]) + __uint_as_float(b[1]);
}
DI float wave_sum(float v, int lane) {
#pragma unroll
  for (int m = 32; m >= 1; m >>= 1) v += shx(v, m, lane);
  return v;
}
DI int bid_l() { int b = blockIdx.x; asm volatile("" : "+s"(b)); return b; }
DI char* ptr_l(char* q) { size_t z = 0; asm volatile("" : "+s"(z)); return q + z; }
DI int crow(int reg, int hh) { return (reg & 3) + 8 * (reg >> 2) + 4 * hh; }
DI float sigmoidf_(float x) { return __builtin_amdgcn_rcpf(1.f + __builtin_amdgcn_exp2f(-x * LOG2E)); }
DI int p64(int d) { return 8 * ((d & 31) >> 2) + (d & 3) + 4 * (d >> 5); }
DI int p32(int d) { return 8 * ((d & 15) >> 2) + (d & 3) + 4 * (d >> 4); }


#define XB_TMO      128
#define XB_XCNT(j)  (256  + 64 * (j))
#define XB_XSUB(j)  (1280 + 64 * (j))
#define XB_XGEN(j)  (2304 + 64 * (j))
#define XB_TOP      3328
#define XB_TOPGEN   3392
#define XB_CENSUS(j) (3456 + 64 * (j))
#define XCD_BAR_WORDS 4096
#define XB_SPIN_CAP (1u << 18)
DI unsigned xb_ld(unsigned* p) { return __hip_atomic_load(p, __ATOMIC_RELAXED, __HIP_MEMORY_SCOPE_AGENT); }
DI unsigned xb_add(unsigned* p, unsigned v) { return __hip_atomic_fetch_add(p, v, __ATOMIC_RELAXED, __HIP_MEMORY_SCOPE_AGENT); }
DI unsigned xb_xcc_id() { return (unsigned)__builtin_amdgcn_s_getreg((3 << 11) | 20) & 0xFu; }
#define XB_SPIN(cond, bar) do { unsigned _sp = 0; while (cond) { __builtin_amdgcn_s_sleep(1); \
    if ((++_sp & 255u) == 0u) { if (xb_ld(&(bar)[XB_TMO])) break; if (_sp > XB_SPIN_CAP) { atomicAdd(&(bar)[XB_TMO], 1u); break; } } } } while (0)
struct XcdBarrier { unsigned* bar; unsigned x; volatile LAS unsigned* st; };
DI XcdBarrier xcd_barrier_post(unsigned* bar, volatile LAS unsigned* st) {
  XcdBarrier b; b.bar = bar; b.x = xb_xcc_id(); b.st = st;
  if (threadIdx.x == 0) (void)xb_add(&bar[XB_XCNT(b.x)], 1u);
  return b;
}
DI void xcd_barrier_complete(unsigned* bar, unsigned x, unsigned& nloc, unsigned& nx) {
  const unsigned G = gridDim.x * gridDim.y * gridDim.z;
  unsigned sum, cnt, mine, sp = 0u;
  for (;;) {
    sum = 0u; cnt = 0u; mine = 0u;
#pragma unroll
    for (unsigned j = 0; j < 16; ++j) { const unsigned c = xb_ld(&bar[XB_XCNT(j)]); sum += c; cnt += (c > 0u) ? 1u : 0u; mine = (j == x) ? c : mine; }
    if (sum == G) break;
    __builtin_amdgcn_s_sleep(1);
    if ((++sp & 255u) == 0u) { if (xb_ld(&bar[XB_TMO])) break; if (sp > XB_SPIN_CAP) { atomicAdd(&bar[XB_TMO], 1u); break; } }
  }
  nloc = mine > 0u ? mine : 1u; nx = cnt > 0u ? cnt : 1u;
}
DI void xcd_barrier(const XcdBarrier& b) {
  asm volatile("s_waitcnt vmcnt(0)" ::: "memory");
  __syncthreads();
  if (threadIdx.x == 0) {
    unsigned* bar = b.bar;
    __builtin_amdgcn_s_waitcnt(0);
    unsigned nloc = b.st[0], nx = b.st[1];
    if (nloc == 0u) { xcd_barrier_complete(bar, b.x, nloc, nx); b.st[0] = nloc; b.st[1] = nx; }
    const unsigned old = xb_add(&bar[XB_XSUB(b.x)], 1u);
    const unsigned gen = old / nloc;
    if (old + 1u == (gen + 1u) * nloc) {
      __builtin_amdgcn_fence(__ATOMIC_RELEASE, "agent");
      asm volatile("s_waitcnt vmcnt(0)" ::: "memory");
      const unsigned og = xb_add(&bar[XB_TOP], 1u);
      const unsigned tg = og / nx;
      if (og + 1u == (tg + 1u) * nx) xb_add(&bar[XB_TOPGEN], 1u);
      else XB_SPIN(xb_ld(&bar[XB_TOPGEN]) == tg, bar);
      __builtin_amdgcn_fence(__ATOMIC_ACQUIRE, "agent");
      xb_add(&bar[XB_XGEN(b.x)], 1u);
      asm volatile("s_waitcnt vmcnt(0)" ::: "memory");
    } else {
      XB_SPIN(xb_ld(&bar[XB_XGEN(b.x)]) == gen, bar);
      __builtin_amdgcn_fence(__ATOMIC_ACQUIRE, "agent");
      asm volatile("s_waitcnt vmcnt(0)" ::: "memory");
    }
  }
  __syncthreads();
}

DI int conv_dst_row(int mode, int r0, int c) {
  if (mode == 1) return r0 + (c & ~63) + p64(c & 63);
  if (mode == 2) return ((c >> 5) % 3 == 2) ? (r0 + (c & ~31) + p32(c & 31)) : (r0 + c);
  if (mode == 3) return r0 + p32(c & 31);
  if (mode == 4) return r0 + (c >> 7) * 256 + (c & 127);
  return r0 + c;
}
DI void conv_job(const float* __restrict__ src, int K, int ld, int c0, int ncols, u16* __restrict__ dst, int r0, int mode,
                 const float* __restrict__ g, u16* sm, int& base) {
  const int nct = (ncols + 63) >> 6, nkt = K >> 6, ntile = nct * nkt;
  const int t = tid_l();
  const int G = gdim_l();
  int first = (bid_l() - (base % G) + G) % G;
  base += ntile;
  for (int tile = first; tile < ntile; tile += G) {
    const int ct = tile % nct, kt = tile / nct;
    const int c = t & 63, kk = t >> 6;
    const bool cv = (ct * 64 + c) < ncols;
    __syncthreads();
#pragma unroll 4
    for (int i = 0; i < 8; ++i) {
      const int k = kk + 8 * i;
      float v = cv ? src[(size_t)(kt * 64 + k) * ld + c0 + ct * 64 + c] : 0.f;
      if (g) v *= g[kt * 64 + k];
      sm[c * 66 + k] = f2bf(v);
    }
    __syncthreads();
    const int row = t >> 3, part = t & 7;
    if (ct * 64 + row < ncols) {
      const unsigned* s32 = (const unsigned*)(sm + row * 66 + part * 8);
      u32x4 a;
      a.x = s32[0]; a.y = s32[1]; a.z = s32[2]; a.w = s32[3];
      u16* d = dst + (size_t)conv_dst_row(mode, r0, ct * 64 + row) * K + kt * 64 + part * 8;
      *(u32x4*)d = a;
    }
  }
}

DI void conv_layer(const Params& p, int l, u16* sm) {
  u16* W = (u16*)(ptr_l(p.ws) + OFF_W);
  int base = 0;
  const float* win = p.w_in + (size_t)l * 1024 * 7328;
  const float* gm = p.g_mix + l * 1024;
  const float* gf = p.g_ffn + l * 1024;
  conv_job(win, 1024, 7328, 416, 1536, W + W_IN, 512, 1, gm, sm, base);
  conv_job(win, 1024, 7328, 416 + 1536, 768 + 1536, W + W_IN, 2048, 0, gm, sm, base);
  conv_job(win, 1024, 7328, 4256, 3072, W + W_G, 0, 0, gm, sm, base);
  conv_job(p.w1 + (size_t)l * 1024 * 2816, 1024, 2816, 0, 2816, W + W_13, 0, 4, gf, sm, base);
  conv_job(p.w3 + (size_t)l * 1024 * 2816, 1024, 2816, 0, 2816, W + W_13, 128, 4, gf, sm, base);
  conv_job(p.w2 + (size_t)l * 2816 * 1024, 2816, 1024, 0, 1024, W + W_2, 0, 0, nullptr, sm, base);
  conv_job(p.w_o + (size_t)l * 1024 * 1024, 1024, 1024, 0, 1024, W + W_O, 0, 0, nullptr, sm, base);
  conv_job(win, 1024, 7328, 0, 384, W + W_IN, 0, 0, gm, sm, base);
  conv_job(win, 1024, 7328, 384, 32, W + W_IN, 384, 3, gm, sm, base);
  conv_job(p.w_pa + (size_t)l * 512 * 1024, 512, 1024, 0, 1024, W + W_PA, 0, 0, nullptr, sm, base);
  conv_job(p.w_pc + (size_t)l * 512 * 1024, 512, 1024, 0, 1024, W + W_PC, 0, 0, nullptr, sm, base);
  conv_job(p.w_pb + (size_t)l * 256 * 1024, 256, 1024, 0, 1024, W + W_PB, 0, 0, nullptr, sm, base);
  conv_job(p.w_uq + (size_t)l * 256 * 768, 256, 768, 0, 768, W + W_UQ, 0, 2, p.g_q + l * 256, sm, base);
  conv_job(p.w_ukv + (size_t)l * 128 * 1024, 128, 1024, 0, 1024, W + W_UKV, 0, 0, p.g_kv + l * 128, sm, base);
}

DI void rope_tables(const Params& p) {
  char* ws = ptr_l(p.ws);
  float2* cs64 = (float2*)(ws + OFF_CS64);
  float2* cs32 = (float2*)(ws + OFF_CS32);
  const int stride = gdim_l() * NT;
  for (int i = bid_l() * NT + tid_l(); i < SEQ * 48; i += stride) {
    int pos; float ex; float2* dst;
    if (i < SEQ * 32) { pos = i >> 5; ex = (float)(i & 31) * (1.f / 32.f); dst = cs64 + i; }
    else { const int j = i - SEQ * 32; pos = j >> 4; ex = (float)(j & 15) * (1.f / 16.f); dst = cs32 + j; }
    const float inv = __builtin_amdgcn_exp2f(-ex * 13.287712379549449f);
    const float ang = (float)pos * inv;
    const double tt = (double)ang * 0.15915494309189535;
    const float fr = (float)(tt - floor(tt));
    *dst = make_float2(__builtin_amdgcn_cosf(fr), __builtin_amdgcn_sinf(fr));
  }
}
DI void zero_f32(float* r, int n) {
  const int stride = gdim_l() * NT;
  for (int i = bid_l() * NT + tid_l(); i < n; i += stride) r[i] = 0.f;
}

DI void x16_rows(const float* __restrict__ x, u16* __restrict__ out, float* __restrict__ rowsq) {
  const int t_ = tid_l(); const int lane = t_ & 63, w = t_ >> 6;
  for (int row = bid_l() * 8 + w; row < T; row += gdim_l() * 8) {
    const float4* xr = (const float4*)(x + (size_t)row * 1024);
    float4 v[4]; float ss = 0.f;
#pragma unroll
    for (int i = 0; i < 4; ++i) { v[i] = xr[lane + 64 * i]; ss += v[i].x * v[i].x + v[i].y * v[i].y + v[i].z * v[i].z + v[i].w * v[i].w; }
    ss = wave_sum(ss, lane);
    if (lane < 16) rowsq[(size_t)row * 16 + lane] = (lane == 0) ? ss : 0.f;
#pragma unroll
    for (int i = 0; i < 4; ++i) {
      u32x2 o; o.x = pack2(v[i].x, v[i].y); o.y = pack2(v[i].z, v[i].w);
      *(u32x2*)(out + (size_t)row * 1024 + 4 * (lane + 64 * i)) = o;
    }
  }
}
DI void scale_rows_f32(float* __restrict__ x, const float* __restrict__ rowsq, const float* __restrict__ g) {
  const int t_ = tid_l(); const int lane = t_ & 63, w = t_ >> 6;
  for (int row = bid_l() * 8 + w; row < T; row += gdim_l() * 8) {
    float4* xr = (float4*)(x + (size_t)row * 1024);
    float sq_ = 0.f;
    { const f32x4* pr_ = (const f32x4*)rowsq + (size_t)row * 4;
#pragma unroll
      for (int j = 0; j < 4; ++j) { const f32x4 q_ = pr_[j]; sq_ += (q_[0] + q_[1]) + (q_[2] + q_[3]); } }
    const float rs = rsqrtf(sq_ * (1.f / 1024.f) + EPS);
#pragma unroll
    for (int i = 0; i < 4; ++i) {
      const float4 v = xr[lane + 64 * i];
      const float4 gg = ((const float4*)g)[lane + 64 * i];
      xr[lane + 64 * i] = make_float4(v.x * rs * gg.x, v.y * rs * gg.y, v.z * rs * gg.z, v.w * rs * gg.w);
    }
  }
}
DI void scale_rows_from16(const u16* __restrict__ x16, float* __restrict__ out, const float* __restrict__ rowsq, const float* __restrict__ g) {
  const int t_ = tid_l(); const int lane = t_ & 63, w = t_ >> 6;
  for (int row = bid_l() * 8 + w; row < T; row += gdim_l() * 8) {
    const u32x4* xr = (const u32x4*)(x16 + (size_t)row * 1024);
    float4* orow = (float4*)(out + (size_t)row * 1024);
    const float rs = rsqrtf(rowsq[row] * (1.f / 1024.f) + EPS);
#pragma unroll
    for (int i = 0; i < 2; ++i) {
      const u32x4 v = xr[lane + 64 * i];
      const float4 g0 = ((const float4*)g)[2 * (lane + 64 * i)], g1 = ((const float4*)g)[2 * (lane + 64 * i) + 1];
      orow[2 * (lane + 64 * i)] = make_float4(bflo(v.x) * rs * g0.x, bfhi(v.x) * rs * g0.y, bflo(v.y) * rs * g0.z, bfhi(v.y) * rs * g0.w);
      orow[2 * (lane + 64 * i) + 1] = make_float4(bflo(v.z) * rs * g1.x, bfhi(v.z) * rs * g1.y, bflo(v.w) * rs * g1.z, bfhi(v.w) * rs * g1.w);
    }
  }
}
DI void norm_rows_bf16(const float* __restrict__ x, const float* __restrict__ g, u16* __restrict__ out) {
  const int t_ = tid_l(); const int lane = t_ & 63, w = t_ >> 6;
  for (int row = bid_l() * 8 + w; row < T; row += gdim_l() * 8) {
    const float4* xr = (const float4*)(x + (size_t)row * 1024);
    float4 v[4]; float ss = 0.f;
#pragma unroll
    for (int i = 0; i < 4; ++i) { v[i] = xr[lane + 64 * i]; ss += v[i].x * v[i].x + v[i].y * v[i].y + v[i].z * v[i].z + v[i].w * v[i].w; }
    ss = wave_sum(ss, lane);
    const float rs = rsqrtf(ss * (1.f / 1024.f) + EPS);
#pragma unroll
    for (int i = 0; i < 4; ++i) {
      const float4 gg = ((const float4*)g)[lane + 64 * i];
      u32x2 o; o.x = pack2(v[i].x * rs * gg.x, v[i].y * rs * gg.y); o.y = pack2(v[i].z * rs * gg.z, v[i].w * rs * gg.w);
      *(u32x2*)(out + (size_t)row * 1024 + 4 * (lane + 64 * i)) = o;
    }
  }
}
DI void norm_rows_f32(float* __restrict__ x, const float* __restrict__ g) {
  const int t_ = tid_l(); const int lane = t_ & 63, w = t_ >> 6;
  for (int row = bid_l() * 8 + w; row < T; row += gdim_l() * 8) {
    float4* xr = (float4*)(x + (size_t)row * 1024);
    float4 v[4]; float ss = 0.f;
#pragma unroll
    for (int i = 0; i < 4; ++i) { v[i] = xr[lane + 64 * i]; ss += v[i].x * v[i].x + v[i].y * v[i].y + v[i].z * v[i].z + v[i].w * v[i].w; }
    ss = wave_sum(ss, lane);
    const float rs = rsqrtf(ss * (1.f / 1024.f) + EPS);
#pragma unroll
    for (int i = 0; i < 4; ++i) {
      const float4 gg = ((const float4*)g)[lane + 64 * i];
      xr[lane + 64 * i] = make_float4(v[i].x * rs * gg.x, v[i].y * rs * gg.y, v[i].z * rs * gg.z, v[i].w * rs * gg.w);
    }
  }
}

constexpr int HTB = 128 * 64 * 2;
DI int lds_byte(int r, int c) { const int st = (r >> 4) * 2 + (c >> 5), rr = r & 15, cc = c & 31, ob = rr * 64 + cc * 2; return st * 1024 + (ob ^ (((ob >> 9) & 1) << 5)); }
DI void stage_rc(int b, int& R, int& C) { const int st = b / 1024, sb = b % 1024, swz = sb ^ (((sb >> 9) & 1) << 5); R = (st >> 1) * 16 + swz / 64; C = (st & 1) * 32 + (swz % 64) / 2; }
DI int perm32(int rho) { const int n = rho >> 4, i = rho & 15; return 8 * (i >> 2) + 4 * n + (i & 3); }

struct GUnit {
  const char* A;
  const char* B;
  int lda;
  int akb;
  int nt;
  int pm, pn, tag;
};

DI void static_tile(int L, int nM, int nN, int& pm, int& pn) {
#ifdef GEMM_ROWMAJ
  pm = L / nN; pn = L - pm * nN; return;
#endif
  const int nwg = nM * nN;
  int wgid = L;
  { const int q = nwg / 8, r = nwg % 8, xcd = wgid % 8, off = wgid / 8; wgid = (xcd < r ? xcd * (q + 1) : r * (q + 1) + (xcd - r) * q) + off; }
#ifndef WGM_
#define WGM_ 8
#endif
  const int nig = WGM_ * nN, gid = wgid / nig, fm = gid * WGM_, gsz = (nM - fm) < WGM_ ? (nM - fm) : WGM_;
  pm = fm + ((wgid % nig) % gsz); pn = (wgid % nig) / gsz;
}

template <bool PERM, bool UNI, bool RS, class Sched, class Epi>
DI void gemm_phase(LAS unsigned char* lds, const Sched& S, const Epi& E, const float* rsq = nullptr, float inv_n = 0.f, int np4 = 1) {
  const int tid = tid_l();
  const int wid = __builtin_amdgcn_readfirstlane(tid >> 6), lane = tid & 63, wr = wid >> 2, wc = wid & 3, fr = lane & 15, fq = lane >> 4;
  int R0, C0, R1, C1;
  stage_rc(tid * 16, R0, C0); stage_rc(tid * 16 + 8192, R1, C1);
  const int Rb0 = PERM ? ((R0 & ~31) + perm32(R0 & 31)) : R0, Rb1 = PERM ? ((R1 & ~31) + perm32(R1 & 31)) : R1;
  const unsigned ldsw = (unsigned)wid * 1024u;
  const int aoff = lds_byte(wr * 64 + fr, fq * 8), boff = lds_byte(wc * 32 + fr, fq * 8);
#define G_SA(b, h) (((b) * 2 + (h)) * HTB)
#define G_SB(b, h) ((4 + (b) * 2 + (h)) * HTB)
#define G_STAGE(bufoff, gbase, v0, v1) do { \
    __builtin_amdgcn_global_load_lds((const unsigned*)((const char*)(gbase) + (v0)), (LAS unsigned*)(lds + (bufoff) + ldsw), 16, 0, 0); \
    __builtin_amdgcn_global_load_lds((const unsigned*)((const char*)(gbase) + (v1)), (LAS unsigned*)(lds + (bufoff) + ldsw + 8192), 16, 0, 0); } while (0)
#define G_LDA(dst, b, h) do { _Pragma("unroll") for (int m = 0; m < 4; ++m) _Pragma("unroll") for (int k = 0; k < 2; ++k) dst[m][k] = *(const LAS bf16x8*)(lds + G_SA(b, h) + aoff + m * 2048 + k * 1024); } while (0)
#define G_LDB(dst, b, h) do { _Pragma("unroll") for (int n = 0; n < 2; ++n) _Pragma("unroll") for (int k = 0; k < 2; ++k) dst[n][k] = *(const LAS bf16x8*)(lds + G_SB(b, h) + boff + n * 2048 + k * 1024); } while (0)
#define G_MMA(ai, bj, At, Bt) do { __builtin_amdgcn_s_setprio(1); _Pragma("unroll") for (int m = 0; m < 4; ++m) _Pragma("unroll") for (int n = 0; n < 2; ++n) _Pragma("unroll") for (int k = 0; k < 2; ++k) \
    acc[ai][bj][m][n] = __builtin_amdgcn_mfma_f32_16x16x32_bf16(Bt[n][k], At[m][k], acc[ai][bj][m][n], 0, 0, 0); __builtin_amdgcn_s_setprio(0); } while (0)
#define G_WAIT_V(n) asm volatile("s_waitcnt vmcnt(" #n ")" ::: "memory")
#define G_WAIT_L(n) asm volatile("s_waitcnt lgkmcnt(" #n ")" ::: "memory")
#define G_BAR __builtin_amdgcn_s_barrier()
#define G_SCHED __builtin_amdgcn_sched_barrier(0)
#define G_MKOFF(u, a0, a1, b0, b1) do { a0 = (unsigned)(R0 * (u).lda + C0) * 2u; a1 = (unsigned)(R1 * (u).lda + C1) * 2u; \
    const int K_ = (u).nt * 64; b0 = (unsigned)(Rb0 * K_ + C0) * 2u; b1 = (unsigned)(Rb1 * K_ + C1) * 2u; } while (0)
  GUnit cur, nxt;
  int ui = 0;
  if (!S.next(0, cur)) return;
  f32x4 acc[2][2][4][2];
#pragma unroll
  for (int a = 0; a < 2; ++a)
#pragma unroll
    for (int b = 0; b < 2; ++b)
#pragma unroll
      for (int m = 0; m < 4; ++m)
#pragma unroll
        for (int n = 0; n < 2; ++n) acc[a][b][m][n] = (f32x4){0.f, 0.f, 0.f, 0.f};
  bf16x8 At[4][2], B0[2][2], B1[2][2];
  unsigned vA0, vA1, vB0, vB1;
  G_MKOFF(cur, vA0, vA1, vB0, vB1);
  LAS float* rstab = (LAS float*)(lds + 131072);
  if (RS && tid < 256) {
    const f32x4* pr_ = (const f32x4*)rsq + (size_t)(cur.pm * 256 + tid) * np4; float s_ = 0.f;
    for (int j = 0; j < np4; ++j) { const f32x4 q_ = pr_[j]; s_ += (q_[0] + q_[1]) + (q_[2] + q_[3]); }
    rstab[tid] = rsqrtf(s_ * inv_n + EPS);
  }
  const char* cA = cur.A; const char* cB = cur.B;
  size_t hA = (size_t)128 * cur.lda * 2, hB = (size_t)128 * cur.nt * 128, kA = (size_t)cur.akb;
  G_STAGE(G_SB(0, 0), cB, vB0, vB1); G_STAGE(G_SA(0, 0), cA, vA0, vA1); G_STAGE(G_SB(0, 1), cB + hB, vB0, vB1); G_STAGE(G_SA(0, 1), cA + hA, vA0, vA1);
  if (wr == 1) G_BAR;
  G_WAIT_V(4); G_BAR;
  G_STAGE(G_SB(1, 0), cB + 128, vB0, vB1); G_STAGE(G_SA(1, 0), cA + kA, vA0, vA1); G_STAGE(G_SB(1, 1), cB + hB + 128, vB0, vB1);
  G_WAIT_V(6); G_BAR;
  for (;;) {
    const bool has_next = S.next(ui + 1, nxt);
    unsigned nA0 = vA0, nA1 = vA1, nB0 = vB0, nB1 = vB1;
    const char* nA = cA; const char* nB = cB;
    size_t hAn = hA, hBn = hB, kAn = kA;
    if (has_next) { nA = nxt.A; nB = nxt.B; if (!UNI) { G_MKOFF(nxt, nA0, nA1, nB0, nB1); hAn = (size_t)128 * nxt.lda * 2; hBn = (size_t)128 * nxt.nt * 128; kAn = (size_t)nxt.akb; } }
    const int nt = cur.nt;
    for (int t = 0; t < nt; t += 2) {
      const bool last = (t == nt - 2);
      const char* a1 = cA + (size_t)(t + 1) * kA;
      const char* a2 = last ? nA : cA + (size_t)(t + 2) * kA;
      const char* b2 = last ? nB : cB + (size_t)(t + 2) * 128;
      const char* a3 = a2 + ((!UNI && last) ? kAn : kA);
      const char* b3 = b2 + 128;
      const unsigned xA0 = (!UNI && last) ? nA0 : vA0, xA1 = (!UNI && last) ? nA1 : vA1, xB0 = (!UNI && last) ? nB0 : vB0, xB1 = (!UNI && last) ? nB1 : vB1;
      const size_t xhA = (!UNI && last) ? hAn : hA, xhB = (!UNI && last) ? hBn : hB;
      G_LDB(B0, 0, 0); G_SCHED; G_LDA(At, 0, 0); G_STAGE(G_SA(1, 1), a1 + hA, vA0, vA1);
      G_WAIT_L(8); G_BAR; G_WAIT_L(0); G_MMA(0, 0, At, B0); G_BAR; G_SCHED;
      G_LDB(B1, 0, 1); G_STAGE(G_SB(0, 0), b2, xB0, xB1);
      G_BAR; G_WAIT_L(0); G_MMA(0, 1, At, B1); G_BAR;
      G_LDA(At, 0, 1); G_STAGE(G_SA(0, 0), a2, xA0, xA1);
      G_BAR; G_WAIT_L(0); G_MMA(1, 0, At, B0); G_BAR; G_SCHED;
      G_STAGE(G_SB(0, 1), b2 + xhB, xB0, xB1);
      G_WAIT_V(6); G_BAR; G_MMA(1, 1, At, B1); G_BAR;
      G_LDB(B0, 1, 0); G_SCHED; G_LDA(At, 1, 0); G_STAGE(G_SA(0, 1), a2 + xhA, xA0, xA1);
      G_WAIT_L(8); G_BAR; G_WAIT_L(0); G_MMA(0, 0, At, B0); G_BAR; G_SCHED;
      G_LDB(B1, 1, 1); G_STAGE(G_SB(1, 0), b3, xB0, xB1);
      G_BAR; G_WAIT_L(0); G_MMA(0, 1, At, B1); G_BAR;
      G_LDA(At, 1, 1); G_STAGE(G_SA(1, 0), a3, xA0, xA1);
      G_BAR; G_WAIT_L(0); G_MMA(1, 0, At, B0); G_BAR; G_SCHED;
      G_STAGE(G_SB(1, 1), b3 + xhB, xB0, xB1);
      G_WAIT_V(6); G_BAR; G_MMA(1, 1, At, B1); G_BAR;
    }
    float rnext_ = 0.f;
    if (RS && has_next && tid < 256) {
      const f32x4* pr_ = (const f32x4*)rsq + (size_t)(nxt.pm * 256 + tid) * np4;
      for (int j = 0; j < np4; ++j) { const f32x4 q_ = pr_[j]; rnext_ += (q_[0] + q_[1]) + (q_[2] + q_[3]); }
    }
    E(acc, cur, wr, wc, fr, fq, rstab + (ui & 1) * 256);
    if (RS && has_next && tid < 256) rstab[((ui + 1) & 1) * 256 + tid] = rsqrtf(rnext_ * inv_n + EPS);
    if (!has_next) break;
    if (!(Epi::CARRY && cur.tag < 2)) {
#pragma unroll
      for (int a = 0; a < 2; ++a)
#pragma unroll
        for (int b = 0; b < 2; ++b)
#pragma unroll
          for (int m = 0; m < 4; ++m)
#pragma unroll
            for (int n = 0; n < 2; ++n) acc[a][b][m][n] = (f32x4){0.f, 0.f, 0.f, 0.f};
    }
    cur = nxt; cA = nA; cB = nB; vA0 = nA0; vA1 = nA1; vB0 = nB0; vB1 = nB1; hA = hAn; hB = hBn; kA = kAn; ++ui;
  }
  G_WAIT_V(0);
  if (wr == 0) G_BAR;
  G_BAR;
#undef G_SA
#undef G_SB
#undef G_STAGE
#undef G_LDA
#undef G_LDB
#undef G_MMA
#undef G_WAIT_V
#undef G_WAIT_L
#undef G_BAR
#undef G_SCHED
#undef G_MKOFF
}

struct SchedSimple {
  const char* A; const char* B; int lda, akb, nt, nN, G, c;
  DI bool next(int i, GUnit& u) const {
    const int L = i * G + c;
    if (L >= 128 * nN) return false;
    static_tile(L, 128, nN, u.pm, u.pn);
    u.A = A + (size_t)u.pm * 256 * lda * 2; u.B = B + (size_t)u.pn * 256 * nt * 128;
    u.lda = lda; u.akb = akb; u.nt = nt; u.tag = 0;
    return true;
  }
};

DI u32x4 pack8(const f32x4 a, const f32x4 b) {
  u32x4 w; w.x = pack2(a[0], a[1]); w.y = pack2(a[2], a[3]); w.z = pack2(b[0], b[1]); w.w = pack2(b[2], b[3]); return w;
}
DI float sumsq8(const f32x4 a, const f32x4 b) {
  return a[0] * a[0] + a[1] * a[1] + a[2] * a[2] + a[3] * a[3] + b[0] * b[0] + b[1] * b[1] + b[2] * b[2] + b[3] * b[3];
}
DI void rope4(const f32x4 x1, const f32x4 x2, const f32x4 c01, const f32x4 c23, float sc, u32x2& o1, u32x2& o2) {
  const float y10 = (x1[0] * c01[0] - x2[0] * c01[1]) * sc, y20 = (x2[0] * c01[0] + x1[0] * c01[1]) * sc;
  const float y11 = (x1[1] * c01[2] - x2[1] * c01[3]) * sc, y21 = (x2[1] * c01[2] + x1[1] * c01[3]) * sc;
  const float y12 = (x1[2] * c23[0] - x2[2] * c23[1]) * sc, y22 = (x2[2] * c23[0] + x1[2] * c23[1]) * sc;
  const float y13 = (x1[3] * c23[2] - x2[3] * c23[3]) * sc, y23 = (x2[3] * c23[2] + x1[3] * c23[3]) * sc;
  o1.x = pack2(y10, y11); o1.y = pack2(y12, y13); o2.x = pack2(y20, y21); o2.y = pack2(y22, y23);
}
DI int dil_row(int row, int dsh) { const int s_ = row & (SEQ - 1); return (row & ~(SEQ - 1)) + ((s_ & ((1 << dsh) - 1)) << (13 - dsh)) + (s_ >> dsh); }
#define EPI_ROW(it_) (row0 + ((it_) >> 2) * 128 + ((it_) & 3) * 16)
#define EPI_LROW(it_) (wr * 64 + fr + ((it_) >> 2) * 128 + ((it_) & 3) * 16)

struct EpiP1 {
  static constexpr bool CARRY = false;
  char* ws;
  DI void operator()(f32x4 (&acc)[2][2][4][2], const GUnit& u, int wr, int wc, int fr, int fq, const LAS float* rst) const {
    asm volatile("" : "+v"(fr), "+v"(fq));
    u16* CQ = (u16*)(ws + OFF_CQ); u16* CKV = (u16*)(ws + OFF_CKV); u16* KROPE = (u16*)(ws + OFF_KROPE);
    u16* QKVB = (u16*)(ws + OFF_QKVB); u16* QKVC = (u16*)(ws + OFF_QKVC);
    float* RSQ = (float*)(ws + OFF_RSQ);
    const float2* cs64 = (const float2*)(ws + OFF_CS64);
    const float2* cs32 = (const float2*)(ws + OFF_CS32);
    const float QS = 0.125f * LOG2E;
    const int row0 = u.pm * 256 + wr * 64 + fr;
    const int pn = u.pn;
    float rsv[8];
#pragma unroll
    for (int it = 0; it < 8; ++it) rsv[it] = rst[EPI_LROW(it)];
    if (pn < 2) {
      const bool kr = (pn == 1) && (wc == 0);
      f32x4 c01 = {0.f, 0.f, 0.f, 0.f}, c23 = c01;
      if (kr) { const float2* cp = cs32 + (EPI_ROW(0) & (SEQ - 1)) * 16 + 4 * fq; c01 = *(const f32x4*)cp; c23 = *(const f32x4*)(cp + 2); }
#pragma unroll
      for (int it = 0; it < 8; ++it) {
        const int ai = it >> 2, m = it & 3;
        const int row = EPI_ROW(it);
        f32x4 n01 = c01, n23 = c23;
        if (kr && it + 1 < 8) { const float2* cp = cs32 + (EPI_ROW(it + 1) & (SEQ - 1)) * 16 + 4 * fq; n01 = *(const f32x4*)cp; n23 = *(const f32x4*)(cp + 2); }
        float ss = 0.f;
#pragma unroll
        for (int bj = 0; bj < 2; ++bj) {
          const f32x4 v0 = acc[ai][bj][m][0] * rsv[it], v1 = acc[ai][bj][m][1] * rsv[it];
          if (pn == 0) {
            *(u32x4*)(CQ + (size_t)row * 256 + bj * 128 + wc * 32 + 8 * fq) = pack8(v0, v1);
            ss += sumsq8(v0, v1);
          } else if (bj == 0) {
            *(u32x4*)(CKV + (size_t)row * 128 + wc * 32 + 8 * fq) = pack8(v0, v1);
            ss += sumsq8(v0, v1);
          } else if (wc == 0) {
            u32x2 o1, o2;
            rope4(v0, v1, c01, c23, 1.f, o1, o2);
            *(u32x2*)(KROPE + (size_t)row * 32 + 4 * fq) = o1;
            *(u32x2*)(KROPE + (size_t)row * 32 + 16 + 4 * fq) = o2;
          }
        }
        ss = xrows_sum(ss);
        if (fq == 0) ((float*)(ws + (pn == 0 ? OFF_PQ : OFF_PKV)))[(size_t)row * 4 + wc] = ss;
        c01 = n01; c23 = n23;
      }
    } else if (pn < 11) {
      const int tsel = (pn - 2) / 3;
      if (tsel < 2) {
        const int q = (wc & 1) * 4 + fq;
        const float sc = (tsel == 0) ? QS : 1.f;
        const float2* cp0 = cs64 + (EPI_ROW(0) & (SEQ - 1)) * 32 + 4 * q;
        f32x4 c01 = *(const f32x4*)cp0, c23 = *(const f32x4*)(cp0 + 2);
#pragma unroll
        for (int it = 0; it < 8; ++it) {
          const int ai = it >> 2, m = it & 3;
          const int row = EPI_ROW(it);
          f32x4 n01 = c01, n23 = c23;
          if (it + 1 < 8) { const float2* cp = cs64 + (EPI_ROW(it + 1) & (SEQ - 1)) * 32 + 4 * q; n01 = *(const f32x4*)cp; n23 = *(const f32x4*)(cp + 2); }
#pragma unroll
          for (int bj = 0; bj < 2; ++bj) {
            const int colg = (pn - 2) * 256 + bj * 128 + wc * 32;
            u32x2 o1, o2;
            rope4(acc[ai][bj][m][0], acc[ai][bj][m][1], c01, c23, sc * rsv[it], o1, o2);
            u16* d = QKVB + ((size_t)(colg >> 6) * T + dil_row(row, 2 * ((((colg >> 6) % 12)) >> 2))) * 64 + 4 * q;
            *(u32x2*)d = o1;
            *(u32x2*)(d + 32) = o2;
          }
          c01 = n01; c23 = n23;
        }
      } else {
#pragma unroll
        for (int it = 0; it < 8; ++it) {
          const int ai = it >> 2, m = it & 3;
          const int row = EPI_ROW(it);
#pragma unroll
          for (int bj = 0; bj < 2; ++bj) {
            const int colg = (pn - 2) * 256 + bj * 128 + wc * 32;
            *(u32x4*)(QKVB + ((size_t)(colg >> 6) * T + dil_row(row, 2 * ((((colg >> 6) % 12)) >> 2))) * 64 + (colg & 63) + 8 * fq) = pack8(acc[ai][bj][m][0] * rsv[it], acc[ai][bj][m][1] * rsv[it]);
          }
        }
      }
    } else {
      const float sc = (pn - 11 < 2) ? QS : 1.f;
#pragma unroll
      for (int it = 0; it < 8; ++it) {
        const int ai = it >> 2, m = it & 3;
        const int row = EPI_ROW(it);
#pragma unroll
        for (int bj = 0; bj < 2; ++bj) {
          const int cc = (pn - 11) * 256 + bj * 128 + wc * 32 + 8 * fq;
          *(u32x4*)(QKVC + ((size_t)(cc >> 6) * T + row) * 64 + (cc & 63)) = pack8(acc[ai][bj][m][0] * (sc * rsv[it]), acc[ai][bj][m][1] * (sc * rsv[it]));
        }
      }
    }
  }
};

struct EpiP2q {
  static constexpr bool CARRY = false;
  char* ws;
  DI void operator()(f32x4 (&acc)[2][2][4][2], const GUnit& u, int wr, int wc, int fr, int fq, const LAS float* rst) const {
    asm volatile("" : "+v"(fr), "+v"(fq));
    u16* QA = (u16*)(ws + OFF_QA);
    const float2* cs32 = (const float2*)(ws + OFF_CS32);
    const float QS = 0.10206207261596575f * LOG2E;
    const int row0 = u.pm * 256 + wr * 64 + fr;
    float rsv[8];
#pragma unroll
    for (int it = 0; it < 8; ++it) rsv[it] = rst[EPI_LROW(it)] * QS;
#pragma unroll
    for (int bj = 0; bj < 2; ++bj) {
      const int colg = u.pn * 256 + bj * 128 + wc * 32;
      const bool rope = (colg % 96) == 64;
      if (rope) {
        const float2* cp0 = cs32 + (EPI_ROW(0) & (SEQ - 1)) * 16 + 4 * fq;
        f32x4 c01 = *(const f32x4*)cp0, c23 = *(const f32x4*)(cp0 + 2);
#pragma unroll
        for (int it = 0; it < 8; ++it) {
          const int ai = it >> 2, m = it & 3;
          const int row = EPI_ROW(it);
          f32x4 n01 = c01, n23 = c23;
          if (it + 1 < 8) { const float2* cp = cs32 + (EPI_ROW(it + 1) & (SEQ - 1)) * 16 + 4 * fq; n01 = *(const f32x4*)cp; n23 = *(const f32x4*)(cp + 2); }
          u32x2 o1, o2;
          rope4(acc[ai][bj][m][0], acc[ai][bj][m][1], c01, c23, rsv[it], o1, o2);
          *(u32x2*)(QA + (size_t)row * 768 + colg + 4 * fq) = o1;
          *(u32x2*)(QA + (size_t)row * 768 + colg + 16 + 4 * fq) = o2;
          c01 = n01; c23 = n23;
        }
      } else {
#pragma unroll
        for (int it = 0; it < 8; ++it) {
          const int ai = it >> 2, m = it & 3;
          *(u32x4*)(QA + (size_t)EPI_ROW(it) * 768 + colg + 8 * fq) = pack8(acc[ai][bj][m][0] * rsv[it], acc[ai][bj][m][1] * rsv[it]);
        }
      }
    }
  }
};
struct EpiP2kv {
  static constexpr bool CARRY = false;
  char* ws;
  DI void operator()(f32x4 (&acc)[2][2][4][2], const GUnit& u, int wr, int wc, int fr, int fq, const LAS float* rst) const {
    asm volatile("" : "+v"(fr), "+v"(fq));
    u16* KVA = (u16*)(ws + OFF_KVA);
    const float* RSQ = (const float*)(ws + OFF_RSQ);
    const int row0 = u.pm * 256 + wr * 64 + fr;
    float rsv[8];
#pragma unroll
    for (int it = 0; it < 8; ++it) { const f32x4 q_ = ((const f32x4*)(ws + OFF_PKV))[EPI_ROW(it)]; rsv[it] = (q_[0] + q_[1]) + (q_[2] + q_[3]); }
#pragma unroll
    for (int it = 0; it < 8; ++it) {
      const int ai = it >> 2, m = it & 3;
      const int row = EPI_ROW(it);
      const float rs = rsqrtf(rsv[it] * (1.f / 128.f) + EPS);
#pragma unroll
      for (int bj = 0; bj < 2; ++bj)
        *(u32x4*)(KVA + (size_t)row * 1024 + u.pn * 256 + bj * 128 + wc * 32 + 8 * fq) = pack8(acc[ai][bj][m][0] * rs, acc[ai][bj][m][1] * rs);
    }
  }
};

DI unsigned char* gate_ptr(char* ws, int br, int row) {
  if (br == 0) return (unsigned char*)(ws + OFF_KVA) + (size_t)row * 2048;
  if (br == 1) return (unsigned char*)(ws + OFF_QKVB) + (size_t)12 * T * 128 + (size_t)row * 1024;
  return (unsigned char*)(ws + OFF_QKVC) + (size_t)8 * T * 128 + (size_t)row * 1024;
}
DI unsigned pack4_u8(const f32x4 v) {
  unsigned r = 0u;
  r = __builtin_amdgcn_cvt_pk_u8_f32(fmaxf(v[0] * 255.f, 0.51f), 0, r); r = __builtin_amdgcn_cvt_pk_u8_f32(fmaxf(v[1] * 255.f, 0.51f), 1, r);
  r = __builtin_amdgcn_cvt_pk_u8_f32(fmaxf(v[2] * 255.f, 0.51f), 2, r); r = __builtin_amdgcn_cvt_pk_u8_f32(fmaxf(v[3] * 255.f, 0.51f), 3, r);
  return r;
}
DI f32x4 unpack4_u8(unsigned r) {
  const float k = 1.f / 255.f;
  return (f32x4){(float)(r & 0xffu) * k, (float)((r >> 8) & 0xffu) * k, (float)((r >> 16) & 0xffu) * k, (float)(r >> 24) * k};
}
struct EpiGate {
  static constexpr bool CARRY = false;
  char* ws;
  DI void operator()(f32x4 (&acc)[2][2][4][2], const GUnit& u, int wr, int wc, int fr, int fq, const LAS float* rst) const {
    asm volatile("" : "+v"(fr), "+v"(fq));
    const int row0 = u.pm * 256 + wr * 64 + fr;
    const int br = u.pn >> 2;
    const float* RSQ = (const float*)(ws + OFF_RSQ);
    float rsv[8];
#pragma unroll
    for (int it = 0; it < 8; ++it) rsv[it] = rst[EPI_LROW(it)];
#pragma unroll
    for (int it = 0; it < 8; ++it) {
      const int ai = it >> 2, m = it & 3;
      const int row = EPI_ROW(it);
      unsigned char* g = gate_ptr(ws, br, row) + (u.pn & 3) * 256 + wc * 32 + 8 * fq;
      const float rs = rsv[it];
#pragma unroll
      for (int bj = 0; bj < 2; ++bj) {
        f32x4 v0 = acc[ai][bj][m][0] * rs, v1 = acc[ai][bj][m][1] * rs;
#pragma unroll
        for (int e = 0; e < 4; ++e) { v0[e] = sigmoidf_(v0[e]); v1[e] = sigmoidf_(v1[e]); }
        u32x2 gq; gq.x = pack4_u8(v0); gq.y = pack4_u8(v1);
        *(u32x2*)(g + bj * 128) = gq;
      }
    }
  }
};
struct EpiMerge {
  static constexpr bool CARRY = true;
  char* ws; u16* merged;
  DI void operator()(f32x4 (&acc)[2][2][4][2], const GUnit& u, int wr, int wc, int fr, int fq, const LAS float* rst) const {
    asm volatile("" : "+v"(fr), "+v"(fq));
    const int row0 = u.pm * 256 + wr * 64 + fr;
    const int br = u.tag;
    const int col = u.pn * 256 + wc * 32 + 8 * fq;
    const int brn = (br < 2) ? br + 1 : br;
    u32x2 a0, a1, b0, b1;
    {
      const unsigned char* g = gate_ptr(ws, br, EPI_ROW(0)) + col;
      a0 = *(const u32x2*)g; a1 = *(const u32x2*)(g + 128);
      const unsigned char* gn = gate_ptr(ws, brn, EPI_ROW(0)) + col;
      b0 = *(const u32x2*)gn; b1 = *(const u32x2*)(gn + 128);
    }
#pragma unroll
    for (int it = 0; it < 8; ++it) {
      const int ai = it >> 2, m = it & 3;
      const int row = EPI_ROW(it);
      u32x2 na0 = a0, na1 = a1, nb0 = b0, nb1 = b1;
      if (it + 1 < 8) {
        const unsigned char* g = gate_ptr(ws, br, EPI_ROW(it + 1)) + col;
        na0 = *(const u32x2*)g; na1 = *(const u32x2*)(g + 128);
        const unsigned char* gn = gate_ptr(ws, brn, EPI_ROW(it + 1)) + col;
        nb0 = *(const u32x2*)gn; nb1 = *(const u32x2*)(gn + 128);
      }
#pragma unroll
      for (int bj = 0; bj < 2; ++bj) {
        const u32x2 ga = bj ? a1 : a0;
        const u32x2 gb = bj ? b1 : b0;
        f32x4 f0 = unpack4_u8(ga.x), f1 = unpack4_u8(ga.y);
        if (br < 2) {
          const f32x4 d0 = unpack4_u8(gb.x), d1 = unpack4_u8(gb.y);
#pragma unroll
          for (int e = 0; e < 4; ++e) { f0[e] *= __builtin_amdgcn_rcpf(d0[e]); f1[e] *= __builtin_amdgcn_rcpf(d1[e]); }
          acc[ai][bj][m][0] *= f0; acc[ai][bj][m][1] *= f1;
        } else {
          *(u32x4*)(merged + (size_t)row * 1024 + col + bj * 128) = pack8(acc[ai][bj][m][0] * f0, acc[ai][bj][m][1] * f1);
        }
      }
      a0 = na0; a1 = na1; b0 = nb0; b1 = nb1;
    }
  }
};
struct SchedMerge {
  char* ws; int G, c;
  DI bool next(int i, GUnit& u) const {
    const int tile = i / 3, br = i - tile * 3;
    const int L = tile * G + c;
    if (L >= 512) return false;
    static_tile(L, 128, 4, u.pm, u.pn);
    u.tag = br;
    if (br == 0) { u.A = ws + OFF_QA + (size_t)u.pm * 256 * 768 * 2; u.lda = 768; u.akb = 192; u.nt = 8; u.B = ws + OFF_W + (W_PA + (size_t)u.pn * 256 * 512) * 2; }
    else if (br == 1) { u.A = ws + OFF_CQ + (size_t)u.pm * 256 * 256 * 2; u.lda = 256; u.akb = 128; u.nt = 4; u.B = ws + OFF_W + (W_PB + (size_t)u.pn * 256 * 256) * 2; }
    else { u.A = ws + OFF_QKVC + (size_t)u.pm * 256 * 64 * 2; u.lda = 64; u.akb = T * 128; u.nt = 8; u.B = ws + OFF_W + (W_PC + (size_t)u.pn * 256 * 512) * 2; }
    return true;
  }
};
struct EpiResid {
  static constexpr bool CARRY = false;
  const float* xin32; const u16* xin16; float* xout; u16* x16; float* rowsq;
  DI void operator()(f32x4 (&acc)[2][2][4][2], const GUnit& u, int wr, int wc, int fr, int fq, const LAS float* rst) const {
    asm volatile("" : "+v"(fr), "+v"(fq));
    const int row0 = u.pm * 256 + wr * 64 + fr, col0 = u.pn * 256 + wc * 32 + 4 * fq;
    f32x4 b[2][2];
#define RESID_LOAD(dst_, it_) do { const size_t o_ = (size_t)EPI_ROW(it_) * 1024 + col0; \
      _Pragma("unroll") for (int bj = 0; bj < 2; ++bj) _Pragma("unroll") for (int n = 0; n < 2; ++n) { \
        if (xin32) dst_[bj][n] = *(const f32x4*)(xin32 + o_ + bj * 128 + n * 16); \
        else { const u32x2 h_ = *(const u32x2*)(xin16 + o_ + bj * 128 + n * 16); dst_[bj][n] = (f32x4){bflo(h_.x), bfhi(h_.x), bflo(h_.y), bfhi(h_.y)}; } } } while (0)
    RESID_LOAD(b, 0);
#pragma unroll
    for (int it = 0; it < 8; ++it) {
      const int ai = it >> 2, m = it & 3;
      const int row = EPI_ROW(it);
      f32x4 nb[2][2];
#pragma unroll
      for (int bj = 0; bj < 2; ++bj)
#pragma unroll
        for (int n = 0; n < 2; ++n) nb[bj][n] = b[bj][n];
      if (it + 1 < 8) RESID_LOAD(nb, it + 1);
      const size_t off = (size_t)row * 1024 + col0;
      float ss = 0.f;
#pragma unroll
      for (int bj = 0; bj < 2; ++bj)
#pragma unroll
        for (int n = 0; n < 2; ++n) {
          const f32x4 v = b[bj][n] + acc[ai][bj][m][n];
          if (xout) *(f32x4*)(xout + off + bj * 128 + n * 16) = v;
          if (x16) { u32x2 o; o.x = pack2(v[0], v[1]); o.y = pack2(v[2], v[3]); *(u32x2*)(x16 + off + bj * 128 + n * 16) = o; }
          ss += v[0] * v[0] + v[1] * v[1] + v[2] * v[2] + v[3] * v[3];
        }
      ss = xrows_sum(ss);
      if (fq == 0) rowsq[(size_t)row * 16 + u.pn * 4 + wc] = ss;
#pragma unroll
      for (int bj = 0; bj < 2; ++bj)
#pragma unroll
        for (int n = 0; n < 2; ++n) b[bj][n] = nb[bj][n];
    }
#undef RESID_LOAD
  }
};
struct EpiNull {
  static constexpr bool CARRY = false;
  DI void operator()(f32x4 (&acc)[2][2][4][2], const GUnit& u, int wr, int wc, int fr, int fq, const LAS float* rst) const {
    if (acc[0][0][0][0][0] == 123456.789f) *(volatile float*)nullptr = acc[1][1][3][1][3];
  }
};
struct EpiFFN {
  static constexpr bool CARRY = false;
  char* ws;
  DI void operator()(f32x4 (&acc)[2][2][4][2], const GUnit& u, int wr, int wc, int fr, int fq, const LAS float* rst) const {
    asm volatile("" : "+v"(fr), "+v"(fq));
    u16* HID = (u16*)(ws + OFF_QKVB);
    const float* RSQ = (const float*)(ws + OFF_RSQ);
    const int row0 = u.pm * 256 + wr * 64 + fr, col0 = u.pn * 128 + wc * 32 + 8 * fq;
    float rsv[8];
#pragma unroll
    for (int it = 0; it < 8; ++it) rsv[it] = rst[EPI_LROW(it)];
#pragma unroll
    for (int it = 0; it < 8; ++it) {
      const int ai = it >> 2, m = it & 3;
      const float rs = rsv[it];
      f32x4 v[2];
#pragma unroll
      for (int n = 0; n < 2; ++n)
#pragma unroll
        for (int e = 0; e < 4; ++e) { const float a1 = acc[ai][0][m][n][e] * rs; v[n][e] = a1 * sigmoidf_(a1) * (acc[ai][1][m][n][e] * rs); }
#ifdef NT_STORE
      __builtin_nontemporal_store(pack8(v[0], v[1]), (u32x4*)(HID + (size_t)EPI_ROW(it) * 2816 + col0));
#else
      *(u32x4*)(HID + (size_t)EPI_ROW(it) * 2816 + col0) = pack8(v[0], v[1]);
#endif
    }
  }
};


struct EpiFFN_NoLoad {
  char* ws;
  DI void operator()(f32x4 (&acc)[2][2][4][2], const GUnit& u, int wr, int wc, int fr, int fq, const LAS float* rst) const {
    asm volatile("" : "+v"(fr), "+v"(fq));
    u16* HID = (u16*)(ws + OFF_QKVB);
    const int row0 = u.pm * 256 + wr * 64 + fr, col0 = u.pn * 128 + wc * 32 + 8 * fq;
#pragma unroll
    for (int it = 0; it < 8; ++it) {
      const int ai = it >> 2, m = it & 3;
#ifdef PROBE_HALFSTORE
      if (it & 1) continue;
#endif
#ifdef PROBE_TILED
      { const int r_ = EPI_ROW(it), c_ = u.pn * 128 + wc * 32; *(u32x4*)(HID + ((size_t)(r_ >> 4) * 88 + (c_ >> 5)) * 512 + (r_ & 15) * 32 + 8 * fq) = pack8(acc[ai][0][m][0] * acc[ai][1][m][0], acc[ai][0][m][1] * acc[ai][1][m][1]); }
#else
      *(u32x4*)(HID + (size_t)EPI_ROW(it) * 2816 + col0) = pack8(acc[ai][0][m][0] * acc[ai][1][m][0], acc[ai][0][m][1] * acc[ai][1][m][1]);
#endif
    }
  }
};

template <int MODE>
DI void attn_block(const Params& p, int l, int bidx, u16* sm, float* smf_all, u16* oalt = nullptr) {
  constexpr int DQK = (MODE == 0) ? 96 : 64;
  constexpr int KS = DQK / 16, KLD = DQK + 8, VLD = 96;
  constexpr int STG = 64 * KLD + 64 * VLD;
  constexpr int NRK = 2;
  const int t = tid_l(), lane = t & 63, w = t >> 6, l32 = lane & 31, hh = lane >> 5;
  const int half = (MODE == 0) ? 0 : (w >> 2);
  const int wl = (MODE == 0) ? w : (w & 3);
  const int tl = (MODE == 0) ? t : (t & 255);
  const int idx = (MODE == 0) ? bidx : (2 * bidx + half);
  u16* sreg = sm + half * 2 * STG;
  float* smf = smf_all + half * 512;
  char* ws = ptr_l(p.ws);
  const int kk = (MODE == 0) ? (t >> 3) : (tl >> 3);
  const int cx = (MODE == 0) ? (t & 7) : (tl & 7);
  int b, ntiles, NTL;
  u16* qptr;
  int h = 0, g = 0, hh4 = 0, dsh = 0, r = 0, mk0 = 0, L = 0, mq = 0, mq0w = 0;
  int rs0 = 0, qrow = 0, qc = 0, rsq = 0, csq = 0;
  size_t qtok;
  if (MODE == 0) {
    const int qblk = idx & 31; h = (idx >> 5) & 7; b = idx >> 8;
    qtok = (size_t)b * SEQ + qblk * 256 + w * 32 + l32;
    qptr = (u16*)(ws + OFF_QA) + qtok * 768 + h * 96;
    ntiles = 128; NTL = 128;
  } else if (MODE == 1) {
    const int sub = idx & 63; hh4 = (idx >> 6) & 3; g = (idx >> 8) % 3; b = idx / 768;
    dsh = 2 * g; L = SEQ >> dsh;
    const int nqb_sh = 6 - dsh;
    r = sub >> nqb_sh;
    const int qb = sub & ((1 << nqb_sh) - 1);
    h = g * 4 + hh4;
    mq0w = qb * 128 + wl * 32;
    mq = mq0w + l32;
    mk0 = qb * 128 - 64;
    qtok = (size_t)b * SEQ + ((size_t)mq << dsh) + r;
    qptr = (u16*)(ws + OFF_QKVB) + ((size_t)h * T + (size_t)b * SEQ + (size_t)r * L + mq) * 64;
    ntiles = 4; NTL = 4;
  } else {
    const int rp = idx & 63; h = (idx >> 6) & 7; b = idx >> 9;
    qrow = 2 * rp + (wl >> 1); qc = (wl & 1) * 32 + l32;
    qtok = (size_t)b * SEQ + qrow * 64 + qc;
    qptr = (u16*)(ws + OFF_QKVC) + ((size_t)h * T + qtok) * 64;
    rs0 = min(max(2 * rp - 4, 0), 120);
    const int rs1 = min(max(2 * rp + 1 - 4, 0), 120);
    ntiles = rs1 + 8 - rs0; NTL = 9;
    rsq = min(max(qrow - 4, 0), 120);
    csq = min(max(qc - 8, 0), 48);
  }
  float* tb = (float*)((char*)sm + 90112 + half * 8192);
  if (MODE == 2) {
    const float* rp_ = p.rpb + (size_t)(l * 8 + h) * 465;
    for (int i = tl; i < 465; i += 256) { const int r_ = i / 31, j_ = i - r_ * 31; tb[r_ * 128 + 49 + j_] = rp_[i] * LOG2E; }
  }
  bf16x8 qf[KS];
#pragma unroll
  for (int ks = 0; ks < KS; ++ks) qf[ks] = *(const bf16x8*)(qptr + ks * 16 + hh * 8);

  constexpr int NTLC = (MODE == 1) ? 4 : 9;
  u32x4 st_[2][4], x_[4];
#define LOAD_TILE(tt_, D_) do { \
    if (MODE == 1) { \
      int mka_ = mk0 + (tt_) * 64 + kk, mkb_ = mka_ + 32; mka_ = min(max(mka_, 0), L - 1); mkb_ = min(max(mkb_, 0), L - 1); \
      const u16* ba_ = (const u16*)(ws + OFF_QKVB) + ((size_t)(12 + h) * T + (size_t)b * SEQ + (size_t)r * L + mka_) * 64 + cx * 8; \
      const u16* bb_ = (const u16*)(ws + OFF_QKVB) + ((size_t)(12 + h) * T + (size_t)b * SEQ + (size_t)r * L + mkb_) * 64 + cx * 8; \
      D_[0] = *(const u32x4*)(ba_); D_[1] = *(const u32x4*)(bb_); \
      D_[2] = *(const u32x4*)(ba_ + (size_t)12 * T * 64); D_[3] = *(const u32x4*)(bb_ + (size_t)12 * T * 64); \
    } else { \
      const u16* ba_ = (const u16*)(ws + OFF_QKVC) + ((size_t)(8 + h) * T + (size_t)b * SEQ + (rs0 + min((tt_), ntiles - 1)) * 64 + kk) * 64 + cx * 8; \
      D_[0] = *(const u32x4*)(ba_); D_[1] = *(const u32x4*)(ba_ + 32 * 64); \
      D_[2] = *(const u32x4*)(ba_ + (size_t)8 * T * 64); D_[3] = *(const u32x4*)(ba_ + (size_t)8 * T * 64 + 32 * 64); \
    } } while (0)
#define STORE_TILE(stg_, S_) do { \
    u16* sK_ = sreg + (stg_) * STG; u16* sV_ = sK_ + 64 * KLD; \
    *(u32x4*)(sK_ + kk * KLD + cx * 8) = S_[0]; *(u32x4*)(sK_ + (kk + 32) * KLD + cx * 8) = S_[1]; \
    *(u32x4*)(sV_ + kk * VLD + cx * 8) = S_[2]; *(u32x4*)(sV_ + (kk + 32) * VLD + cx * 8) = S_[3]; } while (0)
  LOAD_TILE(0, x_); LOAD_TILE(1, st_[0]); LOAD_TILE(2, st_[1]);
  STORE_TILE(0, x_);
  __syncthreads();

  f32x16 o[2];
#pragma unroll
  for (int i = 0; i < 16; ++i) { o[0][i] = 0.f; o[1][i] = 0.f; }
  float m_run = -1e30f, l_run = 0.f;
  const int li = lane & 15, qd = li >> 2, pp = li & 3, dblk = (lane >> 4) & 1;
  const int voff = (4 * hh + qd) * VLD + 16 * dblk + 4 * pp;

#pragma unroll
  for (int tt = 0; tt < NTLC; ++tt) {
    if (tt + 1 < NTLC) { STORE_TILE((tt + 1) & 1, st_[tt % 2]); if (tt + 3 < NTLC) LOAD_TILE(tt + 3, st_[tt % 2]); }
    const u16* sK = sreg + (tt & 1) * STG;
    const u16* sV = sK + 64 * KLD;
    bool active = true;
    if (MODE == 1) {
      const int klo = mk0 + tt * 64;
      active = !(klo + 63 < mq0w - 64 || klo > mq0w + 95);
    } else if (MODE == 2) {
      const int krow = rs0 + tt;
      active = (krow >= rsq) && (krow < rsq + 8);
    }
    if (active) {
      f32x16 s[2];
      bf16x8 kf[KS][2];
#pragma unroll
      for (int ks = 0; ks < KS; ++ks)
#pragma unroll
        for (int k2 = 0; k2 < 2; ++k2) kf[ks][k2] = *(const bf16x8*)(sK + (k2 * 32 + l32) * KLD + ks * 16 + hh * 8);
      s16x4 vlo[2][2][2], vhi[2][2][2];
#pragma unroll
      for (int k2 = 0; k2 < 2; ++k2)
#pragma unroll
        for (int s2 = 0; s2 < 2; ++s2)
#pragma unroll
          for (int dt = 0; dt < 2; ++dt) {
            const u16* va = sV + (k2 * 32 + 16 * s2) * VLD + voff + dt * 32;
            vlo[k2][s2][dt] = __builtin_amdgcn_ds_read_tr16_b64_v4i16((s16x4 LAS*)(va));
            vhi[k2][s2][dt] = __builtin_amdgcn_ds_read_tr16_b64_v4i16((s16x4 LAS*)(va + 8 * VLD));
          }
#pragma unroll
      for (int k2 = 0; k2 < 2; ++k2)
#pragma unroll
        for (int i = 0; i < 16; ++i) s[k2][i] = 0.f;
#pragma unroll
      for (int ks = 0; ks < KS; ++ks)
#pragma unroll
        for (int k2 = 0; k2 < 2; ++k2) s[k2] = MFMA(kf[ks][k2], qf[ks], s[k2]);
      if (MODE == 1) {
        const int klo = mk0 + tt * 64;
        const int db = klo + 4 * hh - mq + 64;
        const bool edge = (klo < 0) || (klo + 63 >= L);
        if (!edge) {
#pragma unroll
          for (int k2 = 0; k2 < 2; ++k2)
#pragma unroll
            for (int i = 0; i < 16; ++i) {
              const int ci = k2 * 32 + (i & 3) + 8 * (i >> 2);
              s[k2][i] = ((unsigned)(db + ci) <= 128u) ? s[k2][i] : -INFINITY;
            }
        } else {
          const int mb = klo + 4 * hh;
#pragma unroll
          for (int k2 = 0; k2 < 2; ++k2)
#pragma unroll
            for (int i = 0; i < 16; ++i) {
              const int ci = k2 * 32 + (i & 3) + 8 * (i >> 2);
              const bool valid = ((unsigned)(db + ci) <= 128u) && ((unsigned)(mb + ci) < (unsigned)L);
              s[k2][i] = valid ? s[k2][i] : -INFINITY;
            }
        }
      } else if (MODE == 2) {
        const float* tp = tb + (rs0 + tt - qrow + 7) * 128 + 64 + 4 * hh - qc;
        const int e0 = 4 * hh - csq;
        float bv[2][16];
#pragma unroll
        for (int k2 = 0; k2 < 2; ++k2)
#pragma unroll
          for (int i = 0; i < 16; ++i) bv[k2][i] = tp[k2 * 32 + (i & 3) + 8 * (i >> 2)];
#pragma unroll
        for (int k2 = 0; k2 < 2; ++k2)
#pragma unroll
          for (int i = 0; i < 16; ++i) {
            const int ci = k2 * 32 + (i & 3) + 8 * (i >> 2);
            const float sb = s[k2][i] + bv[k2][i];
            s[k2][i] = ((unsigned)(ci + e0) < 16u) ? sb : -INFINITY;
          }
      }
      float mx = s[0][0];
#pragma unroll
      for (int i = 1; i < 16; ++i) mx = fmaxf(mx, s[0][i]);
#pragma unroll
      for (int i = 0; i < 16; ++i) mx = fmaxf(mx, s[1][i]);
      mx = xhalf_max(mx);
      const float mnew = fmaxf(m_run, mx);
      const float alpha = __builtin_amdgcn_exp2f(m_run - mnew);
      m_run = mnew;
      float ps = 0.f;
#pragma unroll
      for (int k2 = 0; k2 < 2; ++k2)
#pragma unroll
        for (int i = 0; i < 16; ++i) { s[k2][i] = __builtin_amdgcn_exp2f(s[k2][i] - mnew); ps += s[k2][i]; }
      l_run = l_run * alpha + ps;
#pragma unroll
      for (int i = 0; i < 16; ++i) { o[0][i] *= alpha; o[1][i] *= alpha; }
#pragma unroll
      for (int k2 = 0; k2 < 2; ++k2)
#pragma unroll
        for (int s2 = 0; s2 < 2; ++s2) {
          u32x4 u;
          u.x = pack2(s[k2][8 * s2 + 0], s[k2][8 * s2 + 1]); u.y = pack2(s[k2][8 * s2 + 2], s[k2][8 * s2 + 3]);
          u.z = pack2(s[k2][8 * s2 + 4], s[k2][8 * s2 + 5]); u.w = pack2(s[k2][8 * s2 + 6], s[k2][8 * s2 + 7]);
          const bf16x8 pf = __builtin_bit_cast(bf16x8, u);
#pragma unroll
          for (int dt = 0; dt < 2; ++dt) {
            const bf16x8 vf = __builtin_shufflevector(vlo[k2][s2][dt], vhi[k2][s2][dt], 0, 1, 2, 3, 4, 5, 6, 7);
            o[dt] = MFMA(vf, pf, o[dt]);
          }
        }
    }
    __syncthreads();
  }
#undef LOAD_TILE
#undef STORE_TILE
  const float l_tot = xhalf_sum(l_run);
  const float inv = __builtin_amdgcn_rcpf(l_tot);
#pragma unroll
  for (int dt = 0; dt < 2; ++dt)
#pragma unroll
    for (int rg = 0; rg < 4; ++rg) {
      u32x2 u;
      u.x = pack2(o[dt][4 * rg] * inv, o[dt][4 * rg + 1] * inv);
      u.y = pack2(o[dt][4 * rg + 2] * inv, o[dt][4 * rg + 3] * inv);
      u16* op_ = !oalt ? qptr : (MODE == 0 ? (oalt + qtok * 768 + h * 96) : (MODE == 1 ? (oalt + qtok * 768 + h * 64) : (oalt + (size_t)T * 768 + qtok * 512 + h * 64)));
      *(u32x2*)(op_ + dt * 32 + 8 * rg + 4 * hh) = u;
    }
  if (MODE == 1) {
    if (hh == 0) {
      float* LB = (float*)(ws + OFF_CKV);
      LB[((size_t)g * T + qtok) * 4 + hh4] = m_run * LN2 + __logf(l_tot);
    }
  }
}

#ifndef MLA_THR
#define MLA_THR 8.f
#endif
DI void attn_mla(const Params& p, int idx, u16* sm, u16* oalt) {
  constexpr int KS = 6, KLD = 104, VLD = 96, NTL = 128, KST = 64 * KLD, VST = 64 * VLD;
  u16* sKr = sm;
  u16* sVr = sm + 4 * KST;
  const int t = tid_l(), lane = t & 63, w = t >> 6, l32 = lane & 31, hh = lane >> 5;
  char* ws = ptr_l(p.ws);
  const int kk = t >> 3, cx = t & 7;
  const int qblk = idx & 31, h = (idx >> 5) & 7, b = idx >> 8;
  const size_t qtok = (size_t)b * SEQ + qblk * 256 + w * 32 + l32;
  u16* qptr = (u16*)(ws + OFF_QA) + qtok * 768 + h * 96;
  bf16x8 qf[KS];
#pragma unroll
  for (int ks = 0; ks < KS; ++ks) qf[ks] = *(const bf16x8*)(qptr + ks * 16 + hh * 8);
  const u16* kvbase = (const u16*)(ws + OFF_KVA) + ((size_t)b * SEQ + kk) * 1024 + h * 128;
  const u16* krbase = (const u16*)(ws + OFF_KROPE) + ((size_t)b * SEQ + kk) * 32;
#define MLA_LD(tk_, tv_, k0_, k1_, v0_) do { \
    k0_ = *(const u32x4*)(kvbase + (size_t)(tk_) * 64 * 1024 + cx * 8); \
    k1_ = *(const u32x4*)(krbase + (size_t)(tk_) * 64 * 32 + (cx & 3) * 8); \
    v0_ = *(const u32x4*)(kvbase + (size_t)(tv_) * 64 * 1024 + 64 + cx * 8); } while (0)
#define MLA_STK(sk_, k0_, k1_) do { u16* sK_ = sKr + (sk_) * KST; \
    *(u32x4*)(sK_ + kk * KLD + cx * 8) = k0_; \
    *(u32x4*)(sK_ + kk * KLD + 64 + (cx & 3) * 8) = k1_; } while (0)
#define MLA_STV(sv_, v0_) do { *(u32x4*)(sVr + (sv_) * VST + kk * VLD + cx * 8) = v0_; } while (0)
  u32x4 ck0, ck1, cv0, nk0, nk1, nv0;
  {
    u32x4 a0, a1, a2, b0, b1, b2;
    MLA_LD(0, 0, a0, a1, a2); MLA_LD(1, 1, b0, b1, cv0); MLA_LD(2, 1, nk0, nk1, b2); MLA_LD(3, 1, ck0, ck1, nv0);
    MLA_STK(0, a0, a1); MLA_STV(0, a2); MLA_STK(1, b0, b1); MLA_STK(2, nk0, nk1);
    unsigned zz = 0u; asm volatile("" : "+v"(zz));
    MLA_STV(3, ((u32x4){zz, zz, zz, zz}));
  }
  __syncthreads();
  const int li = lane & 15, qd = li >> 2, pp_ = li & 3, dblk = (lane >> 4) & 1;
  const int voff = (4 * hh + qd) * VLD + 16 * dblk + 4 * pp_;
  const int koff = l32 * KLD + hh * 8;
  f32x16 o[2], sA[2], sB[2], mneg;
#pragma unroll
  for (int i = 0; i < 16; ++i) { o[0][i] = 0.f; o[1][i] = 0.f; sA[0][i] = 0.f; sA[1][i] = 0.f; }
#pragma unroll
  for (int ks = 0; ks < KS; ++ks)
#pragma unroll
    for (int k2 = 0; k2 < 2; ++k2) sA[k2] = MFMA(*(const bf16x8*)(sKr + k2 * 32 * KLD + koff + ks * 16), qf[ks], sA[k2]);
  float m_run, l_run = 0.f;
  {
    float mx = sA[0][0];
#pragma unroll
    for (int i = 1; i < 16; ++i) mx = fmaxf(mx, sA[0][i]);
#pragma unroll
    for (int i = 0; i < 16; ++i) mx = fmaxf(mx, sA[1][i]);
    mx = xhalf_max(mx);
    m_run = mx;
#pragma unroll
    for (int i = 0; i < 16; ++i) { sA[0][i] -= mx; sA[1][i] -= mx; mneg[i] = -mx; }
  }
  bf16x8 pp[4];
#pragma unroll
  for (int i = 0; i < 4; ++i) { unsigned zq = 0u; asm volatile("" : "+v"(zq)); pp[i] = __builtin_bit_cast(bf16x8, ((u32x4){zq, zq, zq, zq})); }

#define MLA_BODY(tt, SIN, SOUT, LK0, LK1, LV0, SK0, SK1, SV0) do { \
    { const int tk_ = min((tt) + 4, NTL - 1), tv_ = min((tt) + 2, NTL - 1); MLA_LD(tk_, tv_, LK0, LK1, LV0); } \
    float mx = SIN[0][0]; \
    _Pragma("unroll") for (int i = 1; i < 16; ++i) mx = fmaxf(mx, SIN[0][i]); \
    _Pragma("unroll") for (int i = 0; i < 16; ++i) mx = fmaxf(mx, SIN[1][i]); \
    mx = xhalf_max(mx); \
    if (!__all(mx <= MLA_THR)) { \
      const float dm = fmaxf(mx, 0.f); \
      const float alpha = __builtin_amdgcn_exp2f(-dm); \
      m_run += dm; l_run *= alpha; \
      _Pragma("unroll") for (int i = 0; i < 16; ++i) { o[0][i] *= alpha; o[1][i] *= alpha; SIN[0][i] -= dm; SIN[1][i] -= dm; mneg[i] = -m_run; } \
      _Pragma("unroll") for (int q_ = 0; q_ < 4; ++q_) { \
        u32x4 u_ = __builtin_bit_cast(u32x4, pp[q_]); \
        u_.x = pack2(bflo(u_.x) * alpha, bfhi(u_.x) * alpha); u_.y = pack2(bflo(u_.y) * alpha, bfhi(u_.y) * alpha); \
        u_.z = pack2(bflo(u_.z) * alpha, bfhi(u_.z) * alpha); u_.w = pack2(bflo(u_.w) * alpha, bfhi(u_.w) * alpha); \
        pp[q_] = __builtin_bit_cast(bf16x8, u_); } \
    } \
    const u16* sK = sKr + (((tt) + 1) & 3) * KST + koff; \
    const u16* sV = sVr + (((tt) + 3) & 3) * VST + voff; \
    _Pragma("unroll") for (int k2 = 0; k2 < 2; ++k2) \
      _Pragma("unroll") for (int s2 = 0; s2 < 2; ++s2) \
        _Pragma("unroll") for (int dt = 0; dt < 2; ++dt) { \
          const u16* va = sV + (k2 * 32 + 16 * s2) * VLD + dt * 32; \
          const s16x4 lo = __builtin_amdgcn_ds_read_tr16_b64_v4i16((s16x4 LAS*)(va)); \
          const s16x4 hi = __builtin_amdgcn_ds_read_tr16_b64_v4i16((s16x4 LAS*)(va + 8 * VLD)); \
          o[dt] = MFMA(__builtin_shufflevector(lo, hi, 0, 1, 2, 3, 4, 5, 6, 7), pp[k2 * 2 + s2], o[dt]); \
        } \
    _Pragma("unroll") for (int k2 = 0; k2 < 2; ++k2) SOUT[k2] = MFMA(*(const bf16x8*)(sK + k2 * 32 * KLD), qf[0], mneg); \
    _Pragma("unroll") for (int ks = 1; ks < KS; ++ks) \
      _Pragma("unroll") for (int k2 = 0; k2 < 2; ++k2) SOUT[k2] = MFMA(*(const bf16x8*)(sK + k2 * 32 * KLD + ks * 16), qf[ks], SOUT[k2]); \
    float ps = 0.f; \
    _Pragma("unroll") for (int k2 = 0; k2 < 2; ++k2) \
      _Pragma("unroll") for (int i = 0; i < 16; ++i) { SIN[k2][i] = __builtin_amdgcn_exp2f(SIN[k2][i]); ps += SIN[k2][i]; } \
    l_run += ps; \
    _Pragma("unroll") for (int k2 = 0; k2 < 2; ++k2) \
      _Pragma("unroll") for (int s2 = 0; s2 < 2; ++s2) { \
        u32x4 u_; \
        u_.x = pack2(SIN[k2][8 * s2 + 0], SIN[k2][8 * s2 + 1]); u_.y = pack2(SIN[k2][8 * s2 + 2], SIN[k2][8 * s2 + 3]); \
        u_.z = pack2(SIN[k2][8 * s2 + 4], SIN[k2][8 * s2 + 5]); u_.w = pack2(SIN[k2][8 * s2 + 6], SIN[k2][8 * s2 + 7]); \
        pp[k2 * 2 + s2] = __builtin_bit_cast(bf16x8, u_); } \
    MLA_STK(((tt) + 3) & 3, SK0, SK1); MLA_STV(((tt) + 1) & 3, SV0); \
    __syncthreads(); \
  } while (0)
  for (int t2 = 0; t2 < NTL; t2 += 2) {
    MLA_BODY(t2, sA, sB, nk0, nk1, nv0, ck0, ck1, cv0);
    MLA_BODY(t2 + 1, sB, sA, ck0, ck1, cv0, nk0, nk1, nv0);
  }
#undef MLA_BODY
#undef MLA_LD
#undef MLA_STK
#undef MLA_STV
  {
    const u16* sV = sVr + 3 * VST + voff;
#pragma unroll
    for (int k2 = 0; k2 < 2; ++k2)
#pragma unroll
      for (int s2 = 0; s2 < 2; ++s2)
#pragma unroll
        for (int dt = 0; dt < 2; ++dt) {
          const u16* va = sV + (k2 * 32 + 16 * s2) * VLD + dt * 32;
          const s16x4 lo = __builtin_amdgcn_ds_read_tr16_b64_v4i16((s16x4 LAS*)(va));
          const s16x4 hi = __builtin_amdgcn_ds_read_tr16_b64_v4i16((s16x4 LAS*)(va + 8 * VLD));
          o[dt] = MFMA(__builtin_shufflevector(lo, hi, 0, 1, 2, 3, 4, 5, 6, 7), pp[k2 * 2 + s2], o[dt]);
        }
  }
  __syncthreads();
  const float l_tot = xhalf_sum(l_run);
  const float inv = __builtin_amdgcn_rcpf(l_tot);
  u16* op_ = oalt ? (oalt + qtok * 768 + h * 96) : qptr;
#pragma unroll
  for (int dt = 0; dt < 2; ++dt)
#pragma unroll
    for (int rg = 0; rg < 4; ++rg) {
      u32x2 u;
      u.x = pack2(o[dt][4 * rg] * inv, o[dt][4 * rg + 1] * inv);
      u.y = pack2(o[dt][4 * rg + 2] * inv, o[dt][4 * rg + 3] * inv);
      *(u32x2*)(op_ + dt * 32 + 8 * rg + 4 * hh) = u;
    }
}

DI void phase_attn(const Params& p, int l, u16* sm, float* smf, int probe = 0) {
#ifdef ATTN_TRUE_XCC
  const int G = gdim_l(), bid = bid_l();
#else
  int bid = blockIdx.x; asm volatile("" : "+s"(bid));
  const int G = gdim_l();
#endif
  {
    const int x = bid & 7, G8 = G >> 3;
    if (probe != 2) for (int j = bid >> 3; j < 128; j += G8) {
      const int pair = x * 4 + (j >> 5);
      attn_mla(p, pair * 32 + (j & 31), sm, probe ? (u16*)p.out : nullptr);
    }
  }
  if (probe == 1) return;
  for (int bi = bid; bi < 1536 + 1024; bi += G) {
    if (bi < 1536) attn_block<1>(p, l, bi, sm, smf, probe ? (u16*)p.out : nullptr);
    else attn_block<2>(p, l, bi - 1536, sm, smf, probe ? (u16*)p.out : nullptr);
  }
}

DI void phase_dilmerge(const Params& p) {
  char* ws = ptr_l(p.ws);
  const u16* QKVB = (const u16*)(ws + OFF_QKVB);
  const float* LB = (const float*)(ws + OFF_CKV);
  u16* YB = (u16*)(ws + OFF_CQ);
  const int stride = gdim_l() * NT;
  for (int i = bid_l() * NT + tid_l(); i < T * 32; i += stride) {
    const int tok = i >> 5, c = i & 31, hh4 = c >> 3;
    float ls[3];
#pragma unroll
    for (int g = 0; g < 3; ++g) ls[g] = LB[((size_t)g * T + tok) * 4 + hh4];
    const float mx = fmaxf(ls[0], fmaxf(ls[1], ls[2]));
    float a[3]; float sum = 0.f;
#pragma unroll
    for (int g = 0; g < 3; ++g) { a[g] = __expf(ls[g] - mx); sum += a[g]; }
    const float inv = __builtin_amdgcn_rcpf(sum);
    float acc[8];
#pragma unroll
    for (int j = 0; j < 8; ++j) acc[j] = 0.f;
#pragma unroll
    for (int g = 0; g < 3; ++g) {
      const u32x4 v = *(const u32x4*)(QKVB + ((size_t)(g * 4 + hh4) * T + dil_row(tok, 2 * g)) * 64 + (c & 7) * 8);
      const float al = a[g] * inv;
      acc[0] += al * bflo(v.x); acc[1] += al * bfhi(v.x); acc[2] += al * bflo(v.y); acc[3] += al * bfhi(v.y);
      acc[4] += al * bflo(v.z); acc[5] += al * bfhi(v.z); acc[6] += al * bflo(v.w); acc[7] += al * bfhi(v.w);
    }
    u32x4 o;
    o.x = pack2(acc[0], acc[1]); o.y = pack2(acc[2], acc[3]); o.z = pack2(acc[4], acc[5]); o.w = pack2(acc[6], acc[7]);
    *(u32x4*)(YB + (size_t)tok * 256 + c * 8) = o;
  }
}

__global__ void __launch_bounds__(NT, 2) mk_forward(Params p) {
  cg::grid_group grid = cg::this_grid();
#define GSYNC() xcd_barrier(xb)
  __shared__ __attribute__((aligned(16))) unsigned char lds_all[131072 + 4096];
  LAS unsigned char* lds = (LAS unsigned char*)lds_all;
  u16* sm = (u16*)lds_all;
  float* smf = (float*)(lds_all + 131072);
  volatile LAS unsigned* xst = (volatile LAS unsigned*)(lds_all + 131072 + 4096 - 32);
  if (threadIdx.x == 0) { xst[0] = 0u; xst[1] = 0u; }
  __syncthreads();
  const XcdBarrier xb = xcd_barrier_post((unsigned*)(p.ws + OFF_BAR), xst);
#pragma unroll 1
  for (int l = 0; l < 2; ++l) {
    const int G = gdim_l();
    char* ws = ptr_l(p.ws);
    const float* xin = (l == 0) ? p.x : p.out;
    conv_layer(p, l, sm);
    float* PA = (float*)(ws + OFF_PA); float* PB = (float*)(ws + OFF_PB);
    if (l == 0) { rope_tables(p); x16_rows(p.x, (u16*)(ws + OFF_H), PA); }
    if (l == 0) grid.sync(); else GSYNC();
#if defined(GEMM_TRUE_XCC)
    const int c = bid_l();
#elif defined(GEMM_CHUNK_XCC)
    const int vb_ = bid_l(); const int c = (vb_ & 7) * 32 + (vb_ >> 3);
#else
    int c = blockIdx.x; asm volatile("" : "+s"(c));
#endif
    {
      SchedSimple S{ws + OFF_H, ws + OFF_W + W_IN * 2, 1024, 128, 16, 17, G, c};
      gemm_phase<true, true, true>(lds, S, EpiP1{ws}, PA, 1.f / 1024.f, 4);
    }
    GSYNC();
    {
      SchedSimple Sq{ws + OFF_CQ, ws + OFF_W + W_UQ * 2, 256, 128, 4, 3, G, c};
      gemm_phase<true, true, true>(lds, Sq, EpiP2q{ws}, (const float*)(ws + OFF_PQ), 1.f / 256.f, 1);
      SchedSimple Skv{ws + OFF_CKV, ws + OFF_W + W_UKV * 2, 128, 128, 2, 4, G, c};
      gemm_phase<true, true, false>(lds, Skv, EpiP2kv{ws});
    }
    GSYNC();
    phase_attn(p, l, sm, smf);
    GSYNC();
    phase_dilmerge(p);
    {
      SchedSimple S{ws + OFF_H, ws + OFF_W + W_G * 2, 1024, 128, 16, 12, G, c};
      gemm_phase<true, true, true>(lds, S, EpiGate{ws}, PA, 1.f / 1024.f, 4);
    }
    GSYNC();
    {
      SchedMerge S{ws, G, c};
      gemm_phase<true, false, false>(lds, S, EpiMerge{ws, (u16*)p.out});
    }
    GSYNC();
    {
      SchedSimple S{(const char*)p.out, ws + OFF_W + W_O * 2, 1024, 128, 16, 4, G, c};
      gemm_phase<false, true, false>(lds, S, EpiResid{(l == 0) ? p.x : nullptr, (l == 0) ? nullptr : (const u16*)(ws + OFF_H), nullptr, (u16*)(ws + OFF_KVA), PB});
    }
    GSYNC();
    {
      SchedSimple S{ws + OFF_KVA, ws + OFF_W + W_13 * 2, 1024, 128, 16, 22, G, c};
      gemm_phase<true, true, true>(lds, S, EpiFFN{ws}, PB, 1.f / 1024.f, 4);
#ifdef PROBE_FFN
      GSYNC(); gemm_phase<true, true, true>(lds, S, EpiFFN{ws}, PB, 1.f / 1024.f, 4);
#endif
#ifdef PROBE_FFN_NOLOAD
      GSYNC(); gemm_phase<true, true, false>(lds, S, EpiFFN_NoLoad{ws}); GSYNC(); gemm_phase<true, true, true>(lds, S, EpiFFN{ws}, PB, 1.f / 1024.f, 4);
#endif
#ifdef PROBE_FFN_NULL
      GSYNC(); gemm_phase<true, true, false>(lds, S, EpiNull{});
#endif
    }
    GSYNC();
    {
      SchedSimple S{ws + OFF_QKVB, ws + OFF_W + W_2 * 2, 2816, 128, 44, 4, G, c};
      gemm_phase<false, true, false>(lds, S, EpiResid{nullptr, (const u16*)(ws + OFF_KVA), (l == 1) ? p.out : nullptr, (l == 1) ? nullptr : (u16*)(ws + OFF_H), PA});
    }
    GSYNC();
  }
  scale_rows_f32(p.out, (const float*)(p.ws + OFF_PA), p.g_final);
}

extern "C" void kernel_launch(void* const* d_in, const int* in_sizes, int n_in, void* d_out, int out_size, void* d_ws,
                              size_t ws_size, hipStream_t stream) {
  static int grid_blocks = 0;
  if (!grid_blocks) {
    int dev = 0, cus = 0, per_cu = 0;
    (void)hipGetDevice(&dev);
    (void)hipDeviceGetAttribute(&cus, hipDeviceAttributeMultiprocessorCount, dev);
    (void)hipOccupancyMaxActiveBlocksPerMultiprocessor(&per_cu, mk_forward, NT, 0);
    if (per_cu < 1) per_cu = 1;
    grid_blocks = cus;
    if (grid_blocks > 256) grid_blocks = 256;
  }
  Params p{};
  p.x = (const float*)d_in[0]; p.w_in = (const float*)d_in[1]; p.g_mix = (const float*)d_in[2];
  p.g_q = (const float*)d_in[3]; p.g_kv = (const float*)d_in[4]; p.w_uq = (const float*)d_in[5];
  p.w_ukv = (const float*)d_in[6]; p.rpb = (const float*)d_in[7]; p.w_pa = (const float*)d_in[8];
  p.w_pb = (const float*)d_in[9]; p.w_pc = (const float*)d_in[10]; p.w_o = (const float*)d_in[11];
  p.g_ffn = (const float*)d_in[12]; p.w1 = (const float*)d_in[13]; p.w3 = (const float*)d_in[14];
  p.w2 = (const float*)d_in[15]; p.g_final = (const float*)d_in[16];
  p.out = (float*)d_out;
  p.ws = (char*)d_ws;
  (void)hipMemsetAsync((char*)d_ws + OFF_BAR, 0, XCD_BAR_WORDS * 4, stream);
  void* args[] = {&p};
  hipError_t e = hipLaunchCooperativeKernel((void*)mk_forward, dim3(grid_blocks), dim3(NT), args, 0, stream);
  if (e != hipSuccess) fprintf(stderr, "cooperative launch failed: %s (grid %d)\n", hipGetErrorString(e), grid_blocks);
}
```
